# Optimizing an MI355X kernel written in HIP

```python
import math
import jax, jax.numpy as jnp
from jax import lax
import numpy as np

D_MODEL = 1024
BATCH = 8
SEQ = 4096
DEPTH = 1

N_HEADS = 8
QK_NOPE_DIM = 64
QK_ROPE_DIM = 32
QK_HEAD_DIM = QK_NOPE_DIM + QK_ROPE_DIM
V_HEAD_DIM = 64
Q_LORA_RANK = 384
KV_LORA_RANK = 256
ROPE_THETA = 10000.0
Q_BLOCK = 128
SSM_WIDTH = 512
SSM_GROUP = 16
SSM_GROUPS = SSM_WIDTH // SSM_GROUP
SSM_STATE = 64
DT_MIN = 0.001
DT_MAX = 0.1
N_BRANCHES = 2
D_FF = 2816
CONV_WIDTH = 3
EPS = 1e-6

OFF_CQ = 0
OFF_CKV = OFF_CQ + Q_LORA_RANK
OFF_KR = OFF_CKV + KV_LORA_RANK
OFF_U = OFF_KR + QK_ROPE_DIM
OFF_GATE = OFF_U + SSM_WIDTH
D_IN = OFF_GATE + N_BRANCHES * D_MODEL

kernel_name = "hybrid_mla_s5_gated_convffn"


def _rmsnorm(x, g):
    xf = x.astype(jnp.float32)
    y = xf * lax.rsqrt(jnp.mean(xf * xf, axis=-1, keepdims=True) + EPS)
    return (y * g.astype(jnp.float32)).astype(x.dtype)


def _rope(x, cos, sin):
    half = x.shape[-1] // 2
    x1, x2 = x[..., :half], x[..., half:]
    return jnp.concatenate([x1 * cos - x2 * sin, x2 * cos + x1 * sin], axis=-1)


def _rope_tables(positions, dtype):
    inv_freq = ROPE_THETA ** (-jnp.arange(0, QK_ROPE_DIM, 2, dtype=jnp.float32) / QK_ROPE_DIM)
    ang = positions.astype(jnp.float32)[..., None] * inv_freq
    return jnp.cos(ang).astype(dtype), jnp.sin(ang).astype(dtype)


def _mla(c_q, c_kv, k_r, cos, sin, q_norm, w_uq, kv_norm, w_uk, w_uv):
    B, L, _ = c_q.shape
    q = (_rmsnorm(c_q, q_norm) @ w_uq).reshape(B, L, N_HEADS, QK_HEAD_DIM)
    q_nope = q[..., :QK_NOPE_DIM]
    q_rope = _rope(q[..., QK_NOPE_DIM:], cos[:, :, None, :], sin[:, :, None, :])
    ckv = _rmsnorm(c_kv, kv_norm)
    k_nope = (ckv @ w_uk).reshape(B, L, N_HEADS, QK_NOPE_DIM)
    v = (ckv @ w_uv).reshape(B, L, N_HEADS, V_HEAD_DIM)
    k_rope = _rope(k_r, cos, sin)
    scale = 1.0 / math.sqrt(QK_HEAD_DIM)
    nblk = L // Q_BLOCK
    qn_blk = q_nope.reshape(B, nblk, Q_BLOCK, N_HEADS, QK_NOPE_DIM).transpose(1, 0, 2, 3, 4)
    qr_blk = q_rope.reshape(B, nblk, Q_BLOCK, N_HEADS, QK_ROPE_DIM).transpose(1, 0, 2, 3, 4)
    k_idx = jnp.arange(L)

    def block(args):
        qn, qr, i = args
        s = jnp.einsum('bqhd,bkhd->bhqk', qn, k_nope) + jnp.einsum('bqhd,bkd->bhqk', qr, k_rope)
        s = s.astype(jnp.float32) * scale
        q_idx = i * Q_BLOCK + jnp.arange(Q_BLOCK)
        s = jnp.where(k_idx[None, :] <= q_idx[:, None], s, -jnp.inf)
        p = jax.nn.softmax(s, axis=-1).astype(v.dtype)
        return jnp.einsum('bhqk,bkhd->bqhd', p, v)

    out = lax.map(block, (qn_blk, qr_blk, jnp.arange(nblk)))
    return out.transpose(1, 0, 2, 3, 4).reshape(B, L, N_HEADS * V_HEAD_DIM)


def _ssm_combine(e1, e2):
    a1r, a1i, b1r, b1i = e1
    a2r, a2i, b2r, b2i = e2
    return (a2r * a1r - a2i * a1i,
            a2r * a1i + a2i * a1r,
            a2r * b1r - a2i * b1i + b2r,
            a2r * b1i + a2i * b1r + b2i)


def _s5(u, lam_re, lam_im, log_dt, b_re, b_im, c_re, c_im, d_skip, w_glu, b_glu):
    B, L, _ = u.shape
    uf = u.astype(jnp.float32).reshape(B, L, SSM_GROUPS, SSM_GROUP)
    dt = jnp.exp(log_dt.astype(jnp.float32))[:, None]
    lr = lam_re.astype(jnp.float32)
    li = lam_im.astype(jnp.float32)
    mag = jnp.exp(lr * dt)
    ang = li * dt
    a_re, a_im = mag * jnp.cos(ang), mag * jnp.sin(ang)
    den = lr * lr + li * li
    n_re, n_im = a_re - 1.0, a_im
    z_re = (n_re * lr + n_im * li) / den
    z_im = (n_im * lr - n_re * li) / den
    br, bi = b_re.astype(jnp.float32), b_im.astype(jnp.float32)
    bb_re = z_re[..., None] * br - z_im[..., None] * bi
    bb_im = z_re[..., None] * bi + z_im[..., None] * br
    bu_re = jnp.einsum('blgh,gph->blgp', uf, bb_re)
    bu_im = jnp.einsum('blgh,gph->blgp', uf, bb_im)
    a_seq_re = jnp.broadcast_to(a_re, (L, SSM_GROUPS, SSM_STATE))
    a_seq_im = jnp.broadcast_to(a_im, (L, SSM_GROUPS, SSM_STATE))

    def scan_one(bur, bui):
        _, _, sr, si = lax.associative_scan(_ssm_combine, (a_seq_re, a_seq_im, bur, bui), axis=0)
        return sr, si

    s_re, s_im = jax.vmap(scan_one)(bu_re, bu_im)
    y = (jnp.einsum('blgp,ghp->blgh', s_re, c_re.astype(jnp.float32))
         - jnp.einsum('blgp,ghp->blgh', s_im, c_im.astype(jnp.float32))
         + d_skip.astype(jnp.float32) * uf)
    y = jax.nn.gelu(y.reshape(B, L, SSM_WIDTH), approximate=True)
    y = y * jax.nn.sigmoid(y @ w_glu.astype(jnp.float32) + b_glu.astype(jnp.float32))
    return y.astype(u.dtype)


def _causal_dwconv(h, w, b):
    L = h.shape[1]
    hp = jnp.pad(h, ((0, 0), (CONV_WIDTH - 1, 0), (0, 0)))
    out = b
    for k in range(CONV_WIDTH):
        out = out + w[k] * hp[:, k:k + L, :]
    return out


def _conv_ffn(x, w_up, conv_w, conv_b, w_down):
    h = _causal_dwconv(x @ w_up, conv_w, conv_b)
    gate, val = h[..., :D_FF], h[..., D_FF:]
    return (jax.nn.gelu(gate, approximate=True) * val) @ w_down


def setup_inputs(seed: int = 0) -> dict:
    key = jax.random.key(seed)
    ks = iter(jax.random.split(key, 40))

    def nrm(shape, scale):
        return jax.random.normal(next(ks), shape, jnp.float32) * scale

    def gain(n):
        return 1.0 + nrm((DEPTH, n), 0.02)

    x = jax.random.normal(next(ks), (BATCH, SEQ, D_MODEL), jnp.float32)
    offs = jax.random.randint(next(ks), (BATCH, 1), 0, 1024, dtype=jnp.int32)
    positions = offs + jnp.arange(SEQ, dtype=jnp.int32)[None, :]
    lam_im0 = math.pi * jnp.arange(SSM_STATE, dtype=jnp.float32)
    return {
        "x": x,
        "positions": positions,
        "mix_norm_pre": gain(D_MODEL),
        "w_in": nrm((DEPTH, D_MODEL, D_IN), D_MODEL ** -0.5),
        "q_norm": gain(Q_LORA_RANK),
        "w_uq": nrm((DEPTH, Q_LORA_RANK, N_HEADS * QK_HEAD_DIM), Q_LORA_RANK ** -0.5),
        "kv_norm": gain(KV_LORA_RANK),
        "w_uk": nrm((DEPTH, KV_LORA_RANK, N_HEADS * QK_NOPE_DIM), KV_LORA_RANK ** -0.5),
        "w_uv": nrm((DEPTH, KV_LORA_RANK, N_HEADS * V_HEAD_DIM), KV_LORA_RANK ** -0.5),
        "ssm_lambda_re": -0.5 + nrm((DEPTH, SSM_GROUPS, SSM_STATE), 0.01),
        "ssm_lambda_im": lam_im0 + nrm((DEPTH, SSM_GROUPS, SSM_STATE), 0.01),
        "ssm_log_dt": jax.random.uniform(next(ks), (DEPTH, SSM_GROUPS), jnp.float32,
                                          math.log(DT_MIN), math.log(DT_MAX)),
        "ssm_b_re": nrm((DEPTH, SSM_GROUPS, SSM_STATE, SSM_GROUP), (2.0 * SSM_GROUP) ** -0.5),
        "ssm_b_im": nrm((DEPTH, SSM_GROUPS, SSM_STATE, SSM_GROUP), (2.0 * SSM_GROUP) ** -0.5),
        "ssm_c_re": nrm((DEPTH, SSM_GROUPS, SSM_GROUP, SSM_STATE), (2.0 * SSM_STATE) ** -0.5),
        "ssm_c_im": nrm((DEPTH, SSM_GROUPS, SSM_GROUP, SSM_STATE), (2.0 * SSM_STATE) ** -0.5),
        "ssm_d": nrm((DEPTH, SSM_GROUPS, SSM_GROUP), 1.0),
        "w_glu": nrm((DEPTH, SSM_WIDTH, SSM_WIDTH), SSM_WIDTH ** -0.5),
        "b_glu": nrm((DEPTH, SSM_WIDTH), 0.01),
        "w_branch_attn": nrm((DEPTH, N_HEADS * V_HEAD_DIM, D_MODEL), (N_HEADS * V_HEAD_DIM) ** -0.5),
        "w_branch_ssm": nrm((DEPTH, SSM_WIDTH, D_MODEL), SSM_WIDTH ** -0.5),
        "b_gate": nrm((DEPTH, N_BRANCHES * D_MODEL), 0.01),
        "w_out": nrm((DEPTH, D_MODEL, D_MODEL), D_MODEL ** -0.5),
        "mix_norm_post": gain(D_MODEL),
        "ffn_norm_pre": gain(D_MODEL),
        "w_up": nrm((DEPTH, D_MODEL, 2 * D_FF), D_MODEL ** -0.5),
        "conv_w": nrm((DEPTH, CONV_WIDTH, 2 * D_FF), CONV_WIDTH ** -0.5),
        "conv_b": nrm((DEPTH, 2 * D_FF), 0.01),
        "w_down": nrm((DEPTH, D_FF, D_MODEL), D_FF ** -0.5),
        "ffn_norm_post": gain(D_MODEL),
    }


def reference(x, positions, mix_norm_pre, w_in, q_norm, w_uq, kv_norm, w_uk, w_uv,
              ssm_lambda_re, ssm_lambda_im, ssm_log_dt, ssm_b_re, ssm_b_im, ssm_c_re, ssm_c_im,
              ssm_d, w_glu, b_glu, w_branch_attn, w_branch_ssm, b_gate, w_out, mix_norm_post,
              ffn_norm_pre, w_up, conv_w, conv_b, w_down, ffn_norm_post):
    B, L, _ = x.shape
    cos, sin = _rope_tables(positions, x.dtype)
    for layer in range(DEPTH):
        hn = _rmsnorm(x, mix_norm_pre[layer])
        proj = hn @ w_in[layer]
        c_q = proj[..., OFF_CQ:OFF_CKV]
        c_kv = proj[..., OFF_CKV:OFF_KR]
        k_r = proj[..., OFF_KR:OFF_U]
        u = proj[..., OFF_U:OFF_GATE]
        gate_logits = proj[..., OFF_GATE:] + b_gate[layer]
        attn = _mla(c_q, c_kv, k_r, cos, sin, q_norm[layer], w_uq[layer],
                    kv_norm[layer], w_uk[layer], w_uv[layer])
        ssm = _s5(u, ssm_lambda_re[layer], ssm_lambda_im[layer], ssm_log_dt[layer],
                  ssm_b_re[layer], ssm_b_im[layer], ssm_c_re[layer], ssm_c_im[layer],
                  ssm_d[layer], w_glu[layer], b_glu[layer])
        gates = jax.nn.sigmoid(gate_logits.astype(jnp.float32)).astype(x.dtype)
        gates = gates.reshape(B, L, N_BRANCHES, D_MODEL)
        merged = (gates[:, :, 0] * (attn @ w_branch_attn[layer])
                  + gates[:, :, 1] * (ssm @ w_branch_ssm[layer]))
        x = x + _rmsnorm(merged @ w_out[layer], mix_norm_post[layer])
        hn = _rmsnorm(x, ffn_norm_pre[layer])
        ff = _conv_ffn(hn, w_up[layer], conv_w[layer], conv_b[layer], w_down[layer])
        x = x + _rmsnorm(ff, ffn_norm_post[layer])
    return x
```

```cpp
#include <hip/hip_runtime.h>
#include <hip/hip_cooperative_groups.h>
#include <cstdio>
#include <cstdint>
namespace cg = cooperative_groups;

#ifndef SINGLE_LAUNCH
#define SINGLE_LAUNCH 1
#endif
#ifndef NAIVE_GEMM
#define NAIVE_GEMM 0
#endif

typedef unsigned short bf16_t;
typedef short bf16x8 __attribute__((ext_vector_type(8)));
typedef float f32x4 __attribute__((ext_vector_type(4)));
typedef unsigned u32x4 __attribute__((ext_vector_type(4)));
typedef unsigned u32x2 __attribute__((ext_vector_type(2)));
#define LAS __attribute__((address_space(3)))
#define DI __device__ __forceinline__

constexpr int M_TOK = 32768, SEQ = 4096, NBATCH = 8, DM = 1024;
constexpr int NPROJ = 3328, D_IN = 3232;
constexpr int PC_GATE = 0, PC_CQ = 2048, PC_CKV = 2432, PC_U = 2688, PC_KR = 3200;
constexpr int PC_Y = 2048;
constexpr int PC_ATT = 2688;
constexpr int DFF = 2816;
constexpr float EPS = 1e-6f;
constexpr float QSCALE = 0.10206207261596575f * 1.4426950408889634f;

constexpr size_t MiB = 1u << 20;
constexpr size_t WS_W = 0;
constexpr size_t W_IN = 0, W_UQ = W_IN + (size_t)NPROJ * 1024, W_KV = W_UQ + 768 * 384, W_GLU = W_KV + 1024 * 256, W_BA = W_GLU + 512 * 512,
                 W_BS = W_BA + 1024 * 512, W_OUT = W_BS + 1024 * 512, W_UP = W_OUT + 1024 * 1024, W_DN = W_UP + (size_t)5632 * 1024,
                 W_BT1 = W_DN + (size_t)1024 * 2816, W_BT3 = W_BT1 + (size_t)32 * 256 * 256, W_END = W_BT3 + (size_t)32 * 256 * 384;
static_assert(W_END * 2 <= 40 * MiB, "weights region");
constexpr size_t WS_COS = 40 * MiB, WS_SIN = 42 * MiB, WS_SSQP = 44 * MiB;
constexpr size_t WS_HN = 48 * MiB;
constexpr size_t WS_YG = 80 * MiB;
constexpr size_t WS_PROJ = 112 * MiB;
constexpr size_t WS_Q = 320 * MiB;
constexpr size_t WS_KV = 368 * MiB;
constexpr size_t WS_SSMO = 384 * MiB;
constexpr size_t WS_HN2 = 416 * MiB + 8192;
constexpr size_t WS_KR = 432 * MiB;
constexpr size_t WS_UA = 434 * MiB;
constexpr size_t WS_TAB = 484 * MiB;
constexpr size_t WS_BAR = 487 * MiB;
constexpr size_t WS_NEED = 488 * MiB;

constexpr int LDS_RING = 131072, LDS_BYTES = 147456;

struct Params { const float* in[30]; float* out; unsigned char* ws; int ph_lo, ph_hi; };

DI float bf2f(bf16_t v) { return __uint_as_float((unsigned)v << 16); }
DI bf16_t f2bf(float f) { unsigned u = __float_as_uint(f); return (bf16_t)((u + 0x7fffu + ((u >> 16) & 1u)) >> 16); }
typedef float f32x2_t __attribute__((ext_vector_type(2))); typedef __bf16 bf16x2_t __attribute__((ext_vector_type(2)));
DI unsigned pk2(float lo, float hi) { f32x2_t v = {lo, hi}; bf16x2_t b = __builtin_convertvector(v, bf16x2_t); return __builtin_bit_cast(unsigned, b); }
DI float lo16(unsigned u) { return __uint_as_float(u << 16); }
DI float hi16(unsigned u) { return __uint_as_float(u & 0xffff0000u); }
DI void unpack8(const u32x4& w, float (&v)[8]) { v[0] = lo16(w.x); v[1] = hi16(w.x); v[2] = lo16(w.y); v[3] = hi16(w.y); v[4] = lo16(w.z); v[5] = hi16(w.z); v[6] = lo16(w.w); v[7] = hi16(w.w); }
DI u32x4 pack8(const float (&v)[8]) { u32x4 w; w.x = pk2(v[0], v[1]); w.y = pk2(v[2], v[3]); w.z = pk2(v[4], v[5]); w.w = pk2(v[6], v[7]); return w; }
DI float gelu_t(float x) { const float u = x * (1.0f + 0.044715f * x * x); const float e = __builtin_amdgcn_exp2f(-2.3022082f * u); return x * __builtin_amdgcn_rcpf(1.0f + e); }
DI float sigmoid_f(float z) { return __builtin_amdgcn_rcpf(1.0f + __builtin_amdgcn_exp2f(-1.4426950408889634f * z)); }
DI float wave_sum(float v) {
#pragma unroll
    for (int o = 1; o < 64; o <<= 1) v += __shfl_xor(v, o);
    return v;
}
DI float wave_max(float v) {
#pragma unroll
    for (int o = 1; o < 64; o <<= 1) v = fmaxf(v, __shfl_xor(v, o));
    return v;
}
#define LDS_WAIT() asm volatile("s_waitcnt lgkmcnt(0)" ::: "memory")
DI int tid_now() { int t = threadIdx.x; asm volatile("" : "+v"(t)); return t; }

namespace pg8 {
constexpr int BM = 256, BK = 64, HALF = 128, HTB = HALF * BK * 2, NXCD = 8, WGM = 8;
__host__ __device__ __forceinline__ int lds_byte(int r, int c) { const int st = (r >> 4) * 2 + (c >> 5), rr = r & 15, cc = c & 31, ob = rr * 64 + cc * 2; return st * 1024 + (ob ^ (((ob >> 9) & 1) << 5)); }
__host__ __device__ __forceinline__ void stage_rc(int b, int& R, int& C) { const int st = b / 1024, sb = b % 1024, swz = sb ^ (((sb >> 9) & 1) << 5); R = (st >> 1) * 16 + swz / 64; C = (st & 1) * 32 + (swz % 64) / 2; }
__host__ __device__ __forceinline__ int perm32(int rho) { const int n = rho >> 4, i = rho & 15; return 8 * (i >> 2) + 4 * n + (i & 3); }

struct Unit { int pm, pn; };
struct Gemm { const bf16_t* A; const bf16_t* Bt; int lda, ldb, K; long agrp; };
struct Order {
    int nM, nN, nwg, G, c, amul, aoff, mode;
    DI void init(int nM_, int nN_, int G_, int c_, int amul_ = 256, int aoff_ = 0, int mode_ = 0) { nM = nM_; nN = nN_; nwg = nM * nN; G = G_; c = c_; amul = amul_; aoff = aoff_; mode = mode_; if (mode == 1) nwg = nM; }
    DI bool next(int i, Unit& u) const {
        const long L = (long)i * G + c; if (L >= nwg) return false;
        if (mode == 1) { u.pm = (int)L; u.pn = (int)L >> 3; return true; }
        if (mode == 2) { if (i > 0) return false; u.pm = nM; u.pn = nN; return true; }
        int wgid = (int)L; { const int q = nwg / NXCD, r = nwg % NXCD, xcd = wgid % NXCD, off = wgid / NXCD; wgid = (xcd < r ? xcd * (q + 1) : r * (q + 1) + (xcd - r) * q) + off; }
        const int nig = WGM * nN, gid = wgid / nig, fm = gid * WGM, gsz = (nM - fm) < WGM ? (nM - fm) : WGM;
        u.pm = fm + ((wgid % nig) % gsz); u.pn = (wgid % nig) / gsz; return true;
    }
    DI long arow(const Unit& u) const { return (long)u.pm * amul + aoff; }
    DI long brow(const Unit& u) const { return (long)u.pn * 256; }
};

typedef f32x4 Acc[2][2][4][2];

#if NAIVE_GEMM
template <class Epi, bool AFTER_DRAIN = false>
DI void gemm_phase(LAS unsigned char* lds, const Gemm g, const Order& S, const Epi& E) {
    const int tid = threadIdx.x, wid = tid >> 6, lane = tid & 63, wr = wid >> 2, wc = wid & 3, fr = lane & 15, fq = lane >> 4;
    Unit cur;
    for (int ui = 0; S.next(ui, cur); ++ui) {
        Acc acc;
#pragma unroll
        for (int a = 0; a < 2; ++a)
#pragma unroll
            for (int b = 0; b < 2; ++b)
#pragma unroll
                for (int m = 0; m < 4; ++m)
#pragma unroll
                    for (int n = 0; n < 2; ++n) acc[a][b][m][n] = (f32x4){0.f, 0.f, 0.f, 0.f};
        const bf16_t* Ab = g.A + S.arow(cur) * g.lda + (long)(64 * wr + fr) * g.lda;
        const bf16_t* Bb = g.Bt + S.brow(cur) * g.ldb + (long)(32 * wc + 8 * fq) * g.ldb;
        for (int k0 = 0; k0 < g.K; k0 += 8) {
#pragma unroll
            for (int a = 0; a < 2; ++a) {
                float av[4][8];
#pragma unroll
                for (int m = 0; m < 4; ++m) { const u32x4 w = *(const u32x4*)(Ab + (long)(128 * a + 16 * m) * g.lda + k0); unpack8(w, av[m]); }
#pragma unroll
                for (int b = 0; b < 2; ++b)
#pragma unroll
                    for (int n = 0; n < 2; ++n)
#pragma unroll
                        for (int j = 0; j < 4; ++j) {
                            const u32x4 w = *(const u32x4*)(Bb + (long)(128 * b + 4 * n + j) * g.ldb + k0); float bv[8]; unpack8(w, bv);
#pragma unroll
                            for (int m = 0; m < 4; ++m) { float s = acc[a][b][m][n][j];
#pragma unroll
                                for (int e = 0; e < 8; ++e) s += av[m][e] * bv[e];
                                acc[a][b][m][n][j] = s; }
                            asm volatile("" ::: "memory");
                        }
            }
        }
        if (AFTER_DRAIN) __syncthreads();
        E(acc, cur, wr, wc, fr, fq);
    }
    __syncthreads();
}
#else
template <class Epi, bool AFTER_DRAIN = false>
DI void gemm_phase(LAS unsigned char* lds, const Gemm g, const Order& S, const Epi& E) {
    const int tid = tid_now(), wid = __builtin_amdgcn_readfirstlane(tid >> 6), lane = tid & 63, wr = wid >> 2, wc = wid & 3, fr = lane & 15, fq = lane >> 4;
    int nt = g.K / BK; asm volatile("" : "+s"(nt));
    unsigned voffA[2], voffB[2];
#pragma unroll
    for (int i = 0; i < 2; ++i) { int R, C; stage_rc(tid * 16 + i * 8192, R, C); const int Rb = (R & ~31) + perm32(R & 31);
        voffA[i] = g.agrp ? (unsigned)((long)(C >> 4) * g.agrp + R * 16 + (C & 15)) * 2u : (unsigned)(R * g.lda + C) * 2u; voffB[i] = (unsigned)(Rb * g.ldb + C) * 2u; }
    const size_t kstep = (size_t)(BK * 2), kstepA = g.agrp ? (size_t)g.agrp * 8 : kstep;
    const size_t hstepA = (size_t)HALF * g.lda * 2, hstepB = (size_t)HALF * g.ldb * 2;
    const unsigned ldsw = (unsigned)wid * 1024u;
    const int aoff = lds_byte(wr * 64 + fr, fq * 8), boff = lds_byte(wc * 32 + fr, fq * 8);
#define PG8_SA(b, h) (((b) * 2 + (h)) * HTB)
#define PG8_SB(b, h) ((4 + (b) * 2 + (h)) * HTB)
#define PG8_STAGE(bufoff, gbase, voff) do { _Pragma("unroll") for (int _i = 0; _i < 2; ++_i) \
        __builtin_amdgcn_global_load_lds((const unsigned*)((const char*)(gbase) + (voff)[_i]), (LAS unsigned*)(lds + (bufoff) + ldsw + _i * 8192), 16, 0, 0); } while (0)
#define PG8_LDA(dst, b, h) do { _Pragma("unroll") for (int m = 0; m < 4; ++m) _Pragma("unroll") for (int k = 0; k < 2; ++k) dst[m][k] = *(const LAS bf16x8*)(lds + PG8_SA(b, h) + aoff + m * 2048 + k * 1024); } while (0)
#define PG8_LDB(dst, b, h) do { _Pragma("unroll") for (int n = 0; n < 2; ++n) _Pragma("unroll") for (int k = 0; k < 2; ++k) dst[n][k] = *(const LAS bf16x8*)(lds + PG8_SB(b, h) + boff + n * 2048 + k * 1024); } while (0)
#define PG8_MMA(ai, bj, At, Bt) do { __builtin_amdgcn_s_setprio(1); _Pragma("unroll") for (int m = 0; m < 4; ++m) _Pragma("unroll") for (int n = 0; n < 2; ++n) _Pragma("unroll") for (int k = 0; k < 2; ++k) \
        acc[ai][bj][m][n] = __builtin_amdgcn_mfma_f32_16x16x32_bf16(Bt[n][k], At[m][k], acc[ai][bj][m][n], 0, 0, 0); __builtin_amdgcn_s_setprio(0); } while (0)
#define PG8_WAIT_V(n) asm volatile("s_waitcnt vmcnt(" #n ")" ::: "memory")
#define PG8_WAIT_L(n) asm volatile("s_waitcnt lgkmcnt(" #n ")" ::: "memory")
#define PG8_BAR __builtin_amdgcn_s_barrier()
#define PG8_SCHED __builtin_amdgcn_sched_barrier(0)
    Unit cur, nxt; int ui = 0;
    if (!S.next(0, cur)) return;
    Acc acc;
#pragma unroll
    for (int a = 0; a < 2; ++a)
#pragma unroll
        for (int b = 0; b < 2; ++b)
#pragma unroll
            for (int m = 0; m < 4; ++m)
#pragma unroll
                for (int n = 0; n < 2; ++n) acc[a][b][m][n] = (f32x4){0.f, 0.f, 0.f, 0.f};
    bf16x8 At[4][2], B0[2][2], B1[2][2];
    const char* cA = (const char*)g.A + S.arow(cur) * (long)g.lda * 2; const char* cB = (const char*)g.Bt + S.brow(cur) * (long)g.ldb * 2;
    PG8_STAGE(PG8_SB(0, 0), cB, voffB); PG8_STAGE(PG8_SB(0, 1), cB + hstepB, voffB); PG8_STAGE(PG8_SA(0, 0), cA, voffA); PG8_STAGE(PG8_SA(0, 1), cA + hstepA, voffA);
    if (wr == 1) PG8_BAR;
    PG8_WAIT_V(2); PG8_BAR;
    PG8_STAGE(PG8_SB(1, 0), cB + kstep, voffB); PG8_STAGE(PG8_SA(1, 0), cA + kstepA, voffA); PG8_STAGE(PG8_SB(1, 1), cB + hstepB + kstep, voffB);
    PG8_WAIT_V(6); PG8_BAR;
    for (;;) {
        const bool has_next = S.next(ui + 1, nxt);
        const char* nA = has_next ? (const char*)g.A + S.arow(nxt) * (long)g.lda * 2 : cA; const char* nB = has_next ? (const char*)g.Bt + S.brow(nxt) * (long)g.ldb * 2 : cB;
#pragma unroll 1
        for (int t = 0; t < nt; t += 2) {
            const bool last = (t == nt - 2);
            const char* a1 = cA + (size_t)(t + 1) * kstepA;
            const char* a2 = last ? nA : cA + (size_t)(t + 2) * kstepA; const char* b2 = last ? nB : cB + (size_t)(t + 2) * kstep;
            const char* a3 = a2 + kstepA; const char* b3 = b2 + kstep;
            PG8_LDB(B0, 0, 0); PG8_LDB(B1, 0, 1); PG8_SCHED; PG8_LDA(At, 0, 0); PG8_STAGE(PG8_SA(1, 1), a1 + hstepA, voffA);
            PG8_WAIT_V(8); PG8_WAIT_L(0); PG8_BAR; PG8_MMA(0, 0, At, B0); PG8_MMA(0, 1, At, B1); PG8_BAR; PG8_SCHED;
            PG8_LDA(At, 0, 1); PG8_STAGE(PG8_SB(0, 0), b2, voffB); PG8_STAGE(PG8_SB(0, 1), b2 + hstepB, voffB); PG8_STAGE(PG8_SA(0, 0), a2, voffA);
            PG8_WAIT_V(8); PG8_WAIT_L(0); PG8_BAR; PG8_MMA(1, 0, At, B0); PG8_MMA(1, 1, At, B1); PG8_BAR; PG8_SCHED;
            PG8_LDB(B0, 1, 0); PG8_LDB(B1, 1, 1); PG8_SCHED; PG8_LDA(At, 1, 0); PG8_STAGE(PG8_SA(0, 1), a2 + hstepA, voffA);
            PG8_WAIT_V(8); PG8_WAIT_L(0); PG8_BAR; PG8_MMA(0, 0, At, B0); PG8_MMA(0, 1, At, B1); PG8_BAR; PG8_SCHED;
            PG8_LDA(At, 1, 1); PG8_STAGE(PG8_SB(1, 0), b3, voffB); PG8_STAGE(PG8_SB(1, 1), b3 + hstepB, voffB); PG8_STAGE(PG8_SA(1, 0), a3, voffA);
            PG8_WAIT_V(8); PG8_WAIT_L(0); PG8_BAR; PG8_MMA(1, 0, At, B0); PG8_MMA(1, 1, At, B1); PG8_BAR; PG8_SCHED;
        }
        if (wr == 0) PG8_BAR;
        if (!AFTER_DRAIN) E(acc, cur, wr, wc, fr, fq);
        if (!has_next) break;
#pragma unroll
        for (int a = 0; a < 2; ++a)
#pragma unroll
            for (int b = 0; b < 2; ++b)
#pragma unroll
                for (int m = 0; m < 4; ++m)
#pragma unroll
                    for (int n = 0; n < 2; ++n) acc[a][b][m][n] = (f32x4){0.f, 0.f, 0.f, 0.f};
        cur = nxt; cA = nA; cB = nB; ++ui;
        if (wr == 1) PG8_BAR;
    }
    PG8_WAIT_V(0);
    PG8_BAR;
    if (AFTER_DRAIN) E(acc, cur, wr, wc, fr, fq);
#undef PG8_SA
#undef PG8_SB
#undef PG8_STAGE
#undef PG8_LDA
#undef PG8_LDB
#undef PG8_MMA
#undef PG8_WAIT_V
#undef PG8_WAIT_L
#undef PG8_BAR
#undef PG8_SCHED
}
#endif
}
using pg8::Unit; using pg8::Acc;
template <class Epi> DI void gemm_phase_drained(LAS unsigned char* lds, const pg8::Gemm g, const pg8::Order& S, const Epi& E) {
    pg8::Unit un;
    for (int i = 0; S.next(i, un); ++i) { pg8::Order S1 = S; S1.mode = 2; S1.nM = un.pm; S1.nN = un.pn; S1.nwg = 1; S1.c = 0; pg8::gemm_phase<Epi, true>(lds, g, S1, E); }
}

#define EPI_ROWS(ai, m) (128 * (ai) + 64 * wr + 16 * (m) + fr)
DI void acc8(const Acc& acc, int ai, int bj, int m, float (&v)[8]) {
    v[0] = acc[ai][bj][m][0][0]; v[1] = acc[ai][bj][m][0][1]; v[2] = acc[ai][bj][m][0][2]; v[3] = acc[ai][bj][m][0][3];
    v[4] = acc[ai][bj][m][1][0]; v[5] = acc[ai][bj][m][1][1]; v[6] = acc[ai][bj][m][1][2]; v[7] = acc[ai][bj][m][1][3];
}
DI void ld8f(const float* p, float (&v)[8]) { const f32x4 a = *(const f32x4*)p, b = *(const f32x4*)(p + 4); v[0] = a[0]; v[1] = a[1]; v[2] = a[2]; v[3] = a[3]; v[4] = b[0]; v[5] = b[1]; v[6] = b[2]; v[7] = b[3]; }

constexpr int CT_STRIDE = 528;
DI void stage_acc_lds(const Acc& acc, LAS unsigned char* lds, int wr, int wc) {
    int t_ = threadIdx.x; asm volatile("" : "+v"(t_)); const int fr = t_ & 15, fq = (t_ >> 4) & 3;
#pragma unroll
    for (int ai = 0; ai < 2; ++ai)
#pragma unroll
        for (int m = 0; m < 4; ++m)
#pragma unroll
            for (int bj = 0; bj < 2; ++bj) { float v[8]; acc8(acc, ai, bj, m, v);
                *(LAS u32x4*)(lds + EPI_ROWS(ai, m) * CT_STRIDE + (bj * 128 + wc * 32 + 8 * fq) * 2) = pack8(v); }
    LDS_WAIT(); __builtin_amdgcn_s_barrier(); asm volatile("" ::: "memory");
}
DI void lds_ld8(const LAS unsigned char* p, float (&v)[8]) { const u32x4 w_ = *(const LAS u32x4*)p; unpack8(w_, v); }
struct EpiProj {
    bf16_t* proj; bf16_t* ua; float* ssqp; const float* b_gate;
    DI void operator()(Acc& acc, const Unit& u, int wr, int wc, int fr, int fq) const {
        { int t_ = threadIdx.x; asm volatile("" : "+v"(t_)); fr = t_ & 15; fq = (t_ >> 4) & 3; }
#pragma unroll
        for (int bj = 0; bj < 2; ++bj) {
            const int seg = 2 * u.pn + bj, col = seg * 128 + wc * 32 + 8 * fq;
            if (seg < 16) {
                float bv[8]; ld8f(b_gate + col, bv);
#pragma unroll
                for (int ai = 0; ai < 2; ++ai)
#pragma unroll
                    for (int m = 0; m < 4; ++m) { const int row = u.pm * 256 + EPI_ROWS(ai, m); float v[8]; acc8(acc, ai, bj, m, v);
#pragma unroll
                        for (int e = 0; e < 8; ++e) v[e] = sigmoid_f(v[e] + bv[e]);
                        *(u32x4*)(proj + (size_t)row * NPROJ + col) = pack8(v); asm volatile("" ::: "memory"); __builtin_amdgcn_sched_barrier(0); }
            } else if (seg < 21) {
#pragma unroll
                for (int ai = 0; ai < 2; ++ai)
#pragma unroll
                    for (int m = 0; m < 4; ++m) { const int row = u.pm * 256 + EPI_ROWS(ai, m); float v[8]; acc8(acc, ai, bj, m, v);
                        const u32x4 w = pack8(v); *(u32x4*)(proj + (size_t)row * NPROJ + col) = w;
                        float r[8]; unpack8(w, r); float s = 0.f;
#pragma unroll
                        for (int e = 0; e < 8; ++e) s += r[e] * r[e];
                        s += __shfl_xor(s, 16); s += __shfl_xor(s, 32);
                        if (fq == 0) ssqp[((size_t)(seg - 16) * M_TOK + row) * 4 + wc] = s; asm volatile("" ::: "memory"); __builtin_amdgcn_sched_barrier(0); }
            } else if (seg < 25) {
                const int cu = (seg - 21) * 128 + wc * 32 + 8 * fq, g = cu >> 4, h0 = cu & 15;
#pragma unroll
                for (int ai = 0; ai < 2; ++ai)
#pragma unroll
                    for (int m = 0; m < 4; ++m) { const int row = u.pm * 256 + EPI_ROWS(ai, m); float v[8]; acc8(acc, ai, bj, m, v);
                        const int b = row >> 12, t = row & 4095, c = t >> 4, t16 = t & 15;
                        *(u32x4*)(ua + ((size_t)((g * 8 + b) * 256 + c)) * 384 + t16 * 16 + h0) = pack8(v); asm volatile("" ::: "memory"); __builtin_amdgcn_sched_barrier(0); }
            } else if (wc == 0) {
#pragma unroll
                for (int ai = 0; ai < 2; ++ai)
#pragma unroll
                    for (int m = 0; m < 4; ++m) { const int row = u.pm * 256 + EPI_ROWS(ai, m); float v[8]; acc8(acc, ai, bj, m, v);
                        *(u32x4*)(proj + (size_t)row * NPROJ + col) = pack8(v); asm volatile("" ::: "memory"); __builtin_amdgcn_sched_barrier(0); }
            }
        }
    }
};
struct EpiQ {
    bf16_t* q; const float* ssqp; const float* cost; const float* sint; LAS unsigned char* lds;
    DI void operator()(Acc& acc, const Unit& u, int wr, int wc, int fr, int fq) const {
        stage_acc_lds(acc, lds, wr, wc);
        const int tid = threadIdx.x, cg = tid & 31, r0 = tid >> 5;
        const int gcol = u.pn * 256 + 8 * cg, d = gcol % 96;
        for (int it = 0; it < 16; ++it) {
            const int r = r0 + 16 * it; const size_t row = (size_t)u.pm * 256 + r;
            float ssq = 0.f;
#pragma unroll
            for (int i = 0; i < 3; ++i) { const f32x4 s0 = *(const f32x4*)(ssqp + ((size_t)i * M_TOK + row) * 4); ssq += (s0[0] + s0[1]) + (s0[2] + s0[3]); }
            const float sc = rsqrtf(ssq * (1.0f / 384.0f) + EPS) * QSCALE;
            float v[8]; lds_ld8(lds + r * CT_STRIDE + cg * 16, v);
            if (d >= 64) {
                const bool first = (d - 64) < 16; const int i0 = (d - 64) & 15;
                float p[8], cs[8], sn[8]; lds_ld8(lds + r * CT_STRIDE + (first ? cg + 2 : cg - 2) * 16, p);
                ld8f(cost + row * 16 + i0, cs); ld8f(sint + row * 16 + i0, sn);
#pragma unroll
                for (int e = 0; e < 8; ++e) v[e] = first ? v[e] * cs[e] - p[e] * sn[e] : v[e] * cs[e] + p[e] * sn[e];
            }
#pragma unroll
            for (int e = 0; e < 8; ++e) v[e] *= sc;
            *(u32x4*)(q + row * 768 + gcol) = pack8(v);
        }
        LDS_WAIT(); __builtin_amdgcn_s_barrier(); asm volatile("" ::: "memory");
    }
};
struct EpiKV {
    bf16_t* kv; const float* ssqp;
    DI void operator()(Acc& acc, const Unit& u, int wr, int wc, int fr, int fq) const {
        { int t_ = threadIdx.x; asm volatile("" : "+v"(t_)); fr = t_ & 15; fq = (t_ >> 4) & 3; }
#pragma unroll
        for (int ai = 0; ai < 2; ++ai)
#pragma unroll
            for (int m = 0; m < 4; ++m) {
                int row = u.pm * 256 + EPI_ROWS(ai, m); asm volatile("" : "+v"(row) :: "memory");
                const f32x4 s0 = *(const f32x4*)(ssqp + ((size_t)3 * M_TOK + row) * 4), s1 = *(const f32x4*)(ssqp + ((size_t)4 * M_TOK + row) * 4);
                const float ssq = ((s0[0] + s0[1]) + (s0[2] + s0[3])) + ((s1[0] + s1[1]) + (s1[2] + s1[3]));
                const float sc = rsqrtf(ssq * (1.0f / 256.0f) + EPS);
#pragma unroll
                for (int bj = 0; bj < 2; ++bj) { float v[8]; acc8(acc, ai, bj, m, v);
#pragma unroll
                    for (int e = 0; e < 8; ++e) v[e] *= sc;
                    *(u32x4*)(kv + (size_t)row * 1024 + u.pn * 256 + bj * 128 + wc * 32 + 8 * fq) = pack8(v); asm volatile("" ::: "memory"); __builtin_amdgcn_sched_barrier(0); }
            }
    }
};
struct EpiS1 {
    float* sl;
    DI void operator()(Acc& acc, const Unit& u, int wr, int wc, int fr, int fq) const {
        { int t_ = threadIdx.x; asm volatile("" : "+v"(t_)); fr = t_ & 15; fq = (t_ >> 4) & 3; }
#pragma unroll
        for (int ai = 0; ai < 2; ++ai)
#pragma unroll
            for (int m = 0; m < 4; ++m) { const int row = u.pm * 256 + EPI_ROWS(ai, m); float* p = sl + (size_t)row * 128 + wc * 32 + 8 * fq;
                *(f32x4*)p = acc[ai][0][m][0]; *(f32x4*)(p + 4) = acc[ai][0][m][1]; }
    }
};
struct EpiS3 {
    bf16_t* proj; const bf16_t* ua; const float* dskip; LAS unsigned char* lds;
    DI void operator()(Acc& acc, const Unit& u, int wr, int wc, int fr, int fq) const {
        stage_acc_lds(acc, lds, wr, wc);
        const int g = u.pm >> 3, b = u.pm & 7;
        const int tid = threadIdx.x, cg = tid & 31, r0 = tid >> 5, col = 8 * cg, t16 = col >> 4, h0 = col & 15;
        float dv[8]; ld8f(dskip + g * 16 + h0, dv);
        for (int it = 0; it < 16; ++it) {
            const int c = r0 + 16 * it; const size_t row = (size_t)u.pm * 256 + c;
            float v[8], uv[8]; lds_ld8(lds + c * CT_STRIDE + cg * 16, v); unpack8(*(const u32x4*)(ua + row * 384 + col), uv);
#pragma unroll
            for (int e = 0; e < 8; ++e) v[e] = gelu_t(v[e] + dv[e] * uv[e]);
            *(u32x4*)(proj + (((size_t)g * M_TOK + (size_t)b * 4096 + 16 * c + t16) * 16 + h0)) = pack8(v);
        }
        LDS_WAIT(); __builtin_amdgcn_s_barrier(); asm volatile("" ::: "memory");
    }
};
struct EpiGLU {
    const bf16_t* proj; bf16_t* ssmo; const float* b_glu;
    DI void operator()(Acc& acc, const Unit& u, int wr, int wc, int fr, int fq) const {
        { int t_ = threadIdx.x; asm volatile("" : "+v"(t_)); fr = t_ & 15; fq = (t_ >> 4) & 3; }
#pragma unroll
        for (int bj = 0; bj < 2; ++bj) {
            const int col = u.pn * 256 + bj * 128 + wc * 32 + 8 * fq; float bv[8]; ld8f(b_glu + col, bv);
#pragma unroll
            for (int ai = 0; ai < 2; ++ai)
#pragma unroll
                for (int m = 0; m < 4; ++m) { const size_t row = (size_t)u.pm * 256 + EPI_ROWS(ai, m); float v[8], y[8]; acc8(acc, ai, bj, m, v);
                    unpack8(*(const u32x4*)(proj + (((size_t)(col >> 4) * M_TOK + row) * 16 + (col & 15))), y);
#pragma unroll
                    for (int e = 0; e < 8; ++e) v[e] = y[e] * sigmoid_f(v[e] + bv[e]);
                    *(u32x4*)(ssmo + row * 512 + col) = pack8(v); asm volatile("" ::: "memory"); __builtin_amdgcn_sched_barrier(0); }
        }
    }
};
template <int SECOND> struct EpiMerge {
    const bf16_t* proj; bf16_t* merged; bf16_t* outp;
    DI void operator()(Acc& acc, const Unit& u, int wr, int wc, int fr, int fq) const {
        { int t_ = threadIdx.x; asm volatile("" : "+v"(t_)); fr = t_ & 15; fq = (t_ >> 4) & 3; }
#pragma unroll
        for (int bj = 0; bj < 2; ++bj) {
            const int col = u.pn * 256 + bj * 128 + wc * 32 + 8 * fq;
#pragma unroll
            for (int ai = 0; ai < 2; ++ai)
#pragma unroll
                for (int m = 0; m < 4; ++m) { const size_t row = (size_t)u.pm * 256 + EPI_ROWS(ai, m); float v[8], gt[8]; acc8(acc, ai, bj, m, v);
                    unpack8(*(const u32x4*)(proj + row * NPROJ + PC_GATE + SECOND * 1024 + col), gt);
                    if (SECOND) { float o[8]; unpack8(*(const u32x4*)(merged + row * 1024 + col), o);
#pragma unroll
                        for (int e = 0; e < 8; ++e) v[e] = o[e] + gt[e] * v[e]; }
                    else {
#pragma unroll
                        for (int e = 0; e < 8; ++e) v[e] = gt[e] * v[e]; }
                    *(u32x4*)(outp + row * 1024 + col) = pack8(v); asm volatile("" ::: "memory"); __builtin_amdgcn_sched_barrier(0); }
        }
    }
};
struct EpiStore {
    bf16_t* o; int ldc;
    DI void operator()(Acc& acc, const Unit& u, int wr, int wc, int fr, int fq) const {
        { int t_ = threadIdx.x; asm volatile("" : "+v"(t_)); fr = t_ & 15; fq = (t_ >> 4) & 3; }
#pragma unroll
        for (int bj = 0; bj < 2; ++bj) {
            const int col = u.pn * 256 + bj * 128 + wc * 32 + 8 * fq;
#pragma unroll
            for (int ai = 0; ai < 2; ++ai)
#pragma unroll
                for (int m = 0; m < 4; ++m) { const size_t row = (size_t)u.pm * 256 + EPI_ROWS(ai, m); float v[8]; acc8(acc, ai, bj, m, v); *(u32x4*)(o + row * ldc + col) = pack8(v); asm volatile("" ::: "memory"); __builtin_amdgcn_sched_barrier(0); }
        }
    }
};
struct EpiConv {
    const float* cw; const float* cb; bf16_t* abuf; LAS unsigned char* lds;
    DI void operator()(Acc& acc, const Unit& u, int wr, int wc, int fr, int fq) const {
        stage_acc_lds(acc, lds, wr, wc);
        const int tid = threadIdx.x, cg8 = (tid & 15) * 8, r0 = tid >> 4;
        const int R0 = 254 * u.pm - 2, gcol = 128 * u.pn + cg8;
        float w0[2][8], w1[2][8], w2[2][8], bb[2][8];
#pragma unroll
        for (int bj = 0; bj < 2; ++bj) { ld8f(cw + gcol + bj * DFF, w0[bj]); ld8f(cw + 2 * DFF + gcol + bj * DFF, w1[bj]); ld8f(cw + 4 * DFF + gcol + bj * DFF, w2[bj]); ld8f(cb + gcol + bj * DFF, bb[bj]); }
        for (int it = 0; it < 8; ++it) {
            const int r = r0 + 32 * it, R = R0 + r, t = R & 4095;
            if (r >= 2 && R < M_TOK) {
                float hc[2][8];
#pragma unroll
                for (int bj = 0; bj < 2; ++bj) {
                    float v[8], p1[8], p2[8];
                    { const u32x4 w_ = *(const LAS u32x4*)(lds + r * CT_STRIDE + (bj * 128 + cg8) * 2); unpack8(w_, v); }
                    { const u32x4 w_ = *(const LAS u32x4*)(lds + (r - 1) * CT_STRIDE + (bj * 128 + cg8) * 2); unpack8(w_, p1); }
                    { const u32x4 w_ = *(const LAS u32x4*)(lds + (r - 2) * CT_STRIDE + (bj * 128 + cg8) * 2); unpack8(w_, p2); }
#pragma unroll
                    for (int e = 0; e < 8; ++e) { const float q1 = t >= 1 ? p1[e] : 0.f, q2 = t >= 2 ? p2[e] : 0.f; hc[bj][e] = bb[bj][e] + w2[bj][e] * v[e] + w1[bj][e] * q1 + w0[bj][e] * q2; }
                }
                float o[8];
#pragma unroll
                for (int e = 0; e < 8; ++e) o[e] = gelu_t(hc[0][e]) * hc[1][e];
                *(u32x4*)(abuf + (size_t)R * DFF + gcol) = pack8(o);
            }
        }
        LDS_WAIT(); __builtin_amdgcn_s_barrier(); asm volatile("" ::: "memory");
    }
};

#define LANE_IDS const int tid = tid_now(), lane = tid & 63, wave = __builtin_amdgcn_readfirstlane(tid >> 6), gw = blockIdx.x * 8 + wave; (void)lane; (void)gw; (void)wave;
struct Frame {
    LAS unsigned char* lds; int G, NGW;
    const float* in[30]; float* out; unsigned char* ws;
    DI bf16_t* wbf(size_t eoff) const { return (bf16_t*)(ws + WS_W) + eoff; }
};

DI void tr_item(const float* W, int ldw, int ocol0, const float* gain, int k0, bf16_t* WT, int ldt, int n0, LAS float* scr, int lane) {
    { const int r8 = lane >> 3, c4 = (lane & 7) * 4;
#pragma unroll
      for (int i = 0; i < 8; ++i) { const int kk = 8 * i + r8; f32x4 v = {0.f, 0.f, 0.f, 0.f};
        if (ocol0 >= 0) { v = __builtin_nontemporal_load((const f32x4*)(W + (size_t)(k0 + kk) * ldw + ocol0 + c4)); if (gain) v *= gain[k0 + kk]; }
        LAS float* d = scr + kk * 33 + c4; d[0] = v[0]; d[1] = v[1]; d[2] = v[2]; d[3] = v[3]; } }
    LDS_WAIT(); asm volatile("" ::: "memory");
    const int c = lane & 7;
#pragma unroll
    for (int j = 0; j < 4; ++j) { const int n = (lane >> 3) + 8 * j; const LAS float* s = scr + (8 * c) * 33 + n;
        u32x4 o; o.x = pk2(s[0 * 33], s[1 * 33]); o.y = pk2(s[2 * 33], s[3 * 33]); o.z = pk2(s[4 * 33], s[5 * 33]); o.w = pk2(s[6 * 33], s[7 * 33]);
        *(u32x4*)(WT + (size_t)(n0 + n) * ldt + k0 + 8 * c) = o; }
    LDS_WAIT(); asm volatile("" ::: "memory");
}
DI int colmap(int mode, int n0) {
    if (mode == 0) return n0;
    if (mode == 1) { if (n0 < 2048) return 1184 + n0; if (n0 < 2432) return n0 - 2048; if (n0 < 2688) return 384 + (n0 - 2432); if (n0 < 3200) return 672 + (n0 - 2688); if (n0 < 3232) return 640 + (n0 - 3200); return -1; }
    const int tile = n0 >> 8, r = n0 & 255; return r < 128 ? 128 * tile + r : DFF + 128 * tile + (r - 128);
}
DI void prep_matrix(const Frame& F, const float* W, int ldw, int K, int Ndst, const float* gain, bf16_t* WT, int mode, LAS float* scr) {
    LANE_IDS
    const int nblk = Ndst / 32, items = (K / 64) * nblk;
    for (int it = gw; it < items; it += F.NGW) { const int kb = it / nblk, nb = it % nblk; tr_item(W, ldw, colmap(mode, 32 * nb), gain, 64 * kb, WT, K, 32 * nb, scr, lane); }
}

DI void phase0(const Frame& F) {
    LANE_IDS
    LAS float* scr = (LAS float*)(F.lds + wave * 16384);
    {
        constexpr int I_IN = 16 * 104, I_UQ = 6 * 24, I_KV = 4 * 16, I_GLU = 8 * 16, I_B = 8 * 32, I_OUT = 16 * 32, I_UP = 16 * 176, I_DN = 44 * 32;
        constexpr int I_TOT = I_IN + I_UQ + 2 * I_KV + I_GLU + 2 * I_B + I_OUT + I_UP + I_DN;
#define PREP_ONE(W, ldw, K, Ndst, gain, WT, mode, cnt) if (r < (cnt)) { const int nblk_ = (Ndst) / 32, kb_ = r / nblk_, nb_ = r % nblk_; \
            tr_item(W, ldw, colmap(mode, 32 * nb_), gain, 64 * kb_, WT, K, 32 * nb_, scr, lane); continue; } r -= (cnt);
        for (int git = gw; git < I_TOT; git += F.NGW) {
            int r = git;
            PREP_ONE(F.in[25], 5632, 1024, 5632, F.in[24], F.wbf(W_UP), 2, I_UP)
            PREP_ONE(F.in[3], D_IN, 1024, NPROJ, F.in[2], F.wbf(W_IN), 1, I_IN)
            PREP_ONE(F.in[28], 1024, 2816, 1024, nullptr, F.wbf(W_DN), 0, I_DN)
            PREP_ONE(F.in[22], 1024, 1024, 1024, nullptr, F.wbf(W_OUT), 0, I_OUT)
            PREP_ONE(F.in[19], 1024, 512, 1024, nullptr, F.wbf(W_BA), 0, I_B)
            PREP_ONE(F.in[20], 1024, 512, 1024, nullptr, F.wbf(W_BS), 0, I_B)
            PREP_ONE(F.in[5], 768, 384, 768, F.in[4], F.wbf(W_UQ), 0, I_UQ)
            PREP_ONE(F.in[17], 512, 512, 512, nullptr, F.wbf(W_GLU), 0, I_GLU)
            PREP_ONE(F.in[7], 512, 256, 512, F.in[6], F.wbf(W_KV), 0, I_KV)
            PREP_ONE(F.in[8], 512, 256, 512, F.in[6], F.wbf(W_KV) + 512 * 256, 0, I_KV)
        }
#undef PREP_ONE
    }
    bf16_t* HN = (bf16_t*)(F.ws + WS_HN);
    for (int m0 = gw * 2; m0 < M_TOK; m0 += F.NGW * 2) {
        f32x4 v[2][4]; float sq[2] = {0.f, 0.f};
#pragma unroll
        for (int u = 0; u < 2; ++u) { const f32x4* xr = (const f32x4*)(F.in[0] + (size_t)(m0 + u) * DM) + lane;
#pragma unroll
            for (int j = 0; j < 4; ++j) v[u][j] = __builtin_nontemporal_load(xr + 64 * j); }
#pragma unroll
        for (int u = 0; u < 2; ++u)
#pragma unroll
            for (int j = 0; j < 4; ++j) sq[u] += (v[u][j][0] * v[u][j][0] + v[u][j][1] * v[u][j][1]) + (v[u][j][2] * v[u][j][2] + v[u][j][3] * v[u][j][3]);
#pragma unroll
        for (int u = 0; u < 2; ++u) { const float rstd = rsqrtf(wave_sum(sq[u]) * (1.f / DM) + EPS);
            u32x2* o = (u32x2*)(HN + (size_t)(m0 + u) * DM) + lane;
#pragma unroll
            for (int j = 0; j < 4; ++j) { u32x2 w; w.x = pk2(v[u][j][0] * rstd, v[u][j][1] * rstd); w.y = pk2(v[u][j][2] * rstd, v[u][j][3] * rstd); o[64 * j] = w; } }
    }
    const int gt = gw * 64 + lane, NT = F.NGW * 64;
    float* COS = (float*)(F.ws + WS_COS); float* SIN = (float*)(F.ws + WS_SIN); const int* pos = (const int*)F.in[1];
    { const float invf = (float)exp2(-(double)(gt & 15) * (13.287712379549449 / 16.0));
      for (int idx = gt; idx < M_TOK * 16; idx += NT) { const float ang = (float)pos[idx >> 4] * invf; const double rev_ = (double)ang * 0.15915494309189535; const float fr_ = (float)(rev_ - rint(rev_));
        COS[idx] = __builtin_amdgcn_cosf(fr_); SIN[idx] = __builtin_amdgcn_sinf(fr_); } }
    float* APOW = (float*)(F.ws + WS_TAB); float* BBAR = APOW + 32 * 17 * 64 * 2;
    for (int it = NT - 1 - gt; it < 2048 * 17; it += NT) { const int idx = it & 2047, d = it >> 11, g = idx >> 6, p = idx & 63;
        const double dt = exp((double)F.in[11][g]), lr = F.in[9][idx], li = F.in[10][idx];
        const double mag = exp(lr * dt * d), ang = li * dt * d, cr = mag * cos(ang), ci = mag * sin(ang);
        APOW[((g * 17 + d) * 64 + p) * 2] = (float)cr; APOW[((g * 17 + d) * 64 + p) * 2 + 1] = (float)ci;
        if (d == 1) {
            const double den = lr * lr + li * li, nre = cr - 1.0, nim = ci, zre = (nre * lr + nim * li) / den, zim = (nim * lr - nre * li) / den;
            for (int h = 0; h < 16; ++h) { const double br = F.in[12][(size_t)idx * 16 + h], bi = F.in[13][(size_t)idx * 16 + h];
                BBAR[((size_t)idx * 16 + h) * 2] = (float)(zre * br - zim * bi); BBAR[((size_t)idx * 16 + h) * 2 + 1] = (float)(zre * bi + zim * br); } }
    }
}
DI void phase_ssm_mats(const Frame& F) {
    LANE_IDS
    const float* APOW = (const float*)(F.ws + WS_TAB); const float* BBAR = APOW + 32 * 17 * 64 * 2; float* KT = (float*)(F.ws + WS_TAB + 1 * MiB);
    const float* cre = F.in[14]; const float* cim = F.in[15];
    bf16_t* BT1 = F.wbf(W_BT1);
    const int gt = gw * 64 + lane, NT = F.NGW * 64;
    for (int idx = gt; idx < 32 * 256 * 256; idx += NT) { const int k = idx & 255, row = (idx >> 8) & 255, g = idx >> 16, j = k >> 4, hp = k & 15;
        float v = 0.f;
        if (row < 128) { const int p = row & 63; const float ar = APOW[((g * 17 + 15 - j) * 64 + p) * 2], ai = APOW[((g * 17 + 15 - j) * 64 + p) * 2 + 1];
            const float br = BBAR[((size_t)(g * 64 + p) * 16 + hp) * 2], bi = BBAR[((size_t)(g * 64 + p) * 16 + hp) * 2 + 1];
            v = row < 64 ? ar * br - ai * bi : ar * bi + ai * br; }
        BT1[idx] = f2bf(v); }
    for (int idx = gt; idx < 32 * 16 * 256; idx += NT) { const int hp = idx & 15, h = (idx >> 4) & 15, d = (idx >> 8) & 15, g = idx >> 12;
        float v = 0.f;
#pragma unroll 8
        for (int p = 0; p < 64; ++p) { const float ar = APOW[((g * 17 + d) * 64 + p) * 2], ai = APOW[((g * 17 + d) * 64 + p) * 2 + 1];
            const float br = BBAR[((size_t)(g * 64 + p) * 16 + hp) * 2], bi = BBAR[((size_t)(g * 64 + p) * 16 + hp) * 2 + 1];
            v += cre[(size_t)(g * 16 + h) * 64 + p] * (ar * br - ai * bi) - cim[(size_t)(g * 16 + h) * 64 + p] * (ar * bi + ai * br); }
        KT[idx] = v; }
}
DI void phase_ssm_mats2(const Frame& F) {
    LANE_IDS
    const float* APOW = (const float*)(F.ws + WS_TAB); const float* KT = (const float*)(F.ws + WS_TAB + 1 * MiB);
    const float* cre = F.in[14]; const float* cim = F.in[15];
    bf16_t* BT3 = F.wbf(W_BT3);
    const int gt = gw * 64 + lane, NT = F.NGW * 64;
    for (int item = gt; item < 32 * 256 * 48; item += NT) {
        const int k0 = 8 * (item % 48), row = (item / 48) & 255, g = item / (48 * 256), t = row >> 4, h = row & 15;
        float v[8];
#pragma unroll
        for (int e = 0; e < 8; ++e) v[e] = 0.f;
        if (k0 < 256) { const int j = k0 >> 4, hp0 = k0 & 15; if (j <= t) ld8f(KT + ((g * 16 + (t - j)) * 16 + h) * 16 + hp0, v); }
        else { const int p0 = (k0 - 256) & 63; float ap[16], cr[8], ci[8];
            ld8f(APOW + ((g * 17 + t + 1) * 64 + p0) * 2, *(float(*)[8])&ap[0]); ld8f(APOW + ((g * 17 + t + 1) * 64 + p0) * 2 + 8, *(float(*)[8])&ap[8]);
            ld8f(cre + (size_t)(g * 16 + h) * 64 + p0, cr); ld8f(cim + (size_t)(g * 16 + h) * 64 + p0, ci);
#pragma unroll
            for (int e = 0; e < 8; ++e) v[e] = k0 < 320 ? cr[e] * ap[2 * e] - ci[e] * ap[2 * e + 1] : -(cr[e] * ap[2 * e + 1] + ci[e] * ap[2 * e]); }
        *(u32x4*)(BT3 + (size_t)item * 8) = pack8(v);
    }
}
DI void phase_krope(const Frame& F) {
    LANE_IDS
    const bf16_t* PROJ = (const bf16_t*)(F.ws + WS_PROJ); bf16_t* KR = (bf16_t*)(F.ws + WS_KR);
    const float* COS = (const float*)(F.ws + WS_COS); const float* SIN = (const float*)(F.ws + WS_SIN);
    const int gt = gw * 64 + lane, NT = F.NGW * 64;
    for (int idx = gt; idx < M_TOK * 16; idx += NT) { const int m = idx >> 4, i = idx & 15;
        const float x1 = bf2f(PROJ[(size_t)m * NPROJ + PC_KR + i]), x2 = bf2f(PROJ[(size_t)m * NPROJ + PC_KR + 16 + i]), c = COS[idx], s = SIN[idx];
        KR[(size_t)m * 32 + i] = f2bf(x1 * c - x2 * s); KR[(size_t)m * 32 + 16 + i] = f2bf(x2 * c + x1 * s); }
}
DI void phase_scan(const Frame& F) {
    LANE_IDS
    const float* APOW = (const float*)(F.ws + WS_TAB); const float* SL = (const float*)(F.ws + WS_HN); bf16_t* UA = (bf16_t*)(F.ws + WS_UA);
    LAS float* ex = (LAS float*)F.lds;
    const int p = tid & 63, seg = tid >> 6;
    for (int item = blockIdx.x; item < 256; item += F.G) {
        const int g = item >> 3;
        const float a16r = APOW[((g * 17 + 16) * 64 + p) * 2], a16i = APOW[((g * 17 + 16) * 64 + p) * 2 + 1];
        const size_t row0 = (size_t)item * 256 + seg * 32;
        float sr = 0.f, si = 0.f;
#pragma unroll 16
        for (int i = 0; i < 32; ++i) { const float lr = SL[(row0 + i) * 128 + p], li = SL[(row0 + i) * 128 + 64 + p];
            const float nr = a16r * sr - a16i * si + lr, ni = a16r * si + a16i * sr + li; sr = nr; si = ni; }
        ex[(seg * 64 + p) * 2] = sr; ex[(seg * 64 + p) * 2 + 1] = si;
        __syncthreads();
        float pr = a16r, pi = a16i;
#pragma unroll
        for (int q = 0; q < 5; ++q) { const float nr = pr * pr - pi * pi, ni = 2.f * pr * pi; pr = nr; pi = ni; }
        float cr = 0.f, ci = 0.f;
        for (int s2 = 0; s2 < seg; ++s2) { const float er = ex[(s2 * 64 + p) * 2], ei = ex[(s2 * 64 + p) * 2 + 1];
            const float nr = pr * cr - pi * ci + er, ni = pr * ci + pi * cr + ei; cr = nr; ci = ni; }
        sr = cr; si = ci;
#pragma unroll 16
        for (int i = 0; i < 32; ++i) { UA[(row0 + i) * 384 + 256 + p] = f2bf(sr); UA[(row0 + i) * 384 + 320 + p] = f2bf(si);
            const float lr = SL[(row0 + i) * 128 + p], li = SL[(row0 + i) * 128 + 64 + p];
            const float nr = a16r * sr - a16i * si + lr, ni = a16r * si + a16i * sr + li; sr = nr; si = ni; }
        __syncthreads();
    }
}
DI void phase_attn_naive(const Frame& F) {
    LANE_IDS
    const bf16_t* Q = (const bf16_t*)(F.ws + WS_Q); const bf16_t* KV = (const bf16_t*)(F.ws + WS_KV); const bf16_t* KR = (const bf16_t*)(F.ws + WS_KR);
    bf16_t* PROJ = (bf16_t*)(F.ws + WS_PROJ);
    for (int task = gw; task < NBATCH * 8 * SEQ; task += F.NGW) {
        const int qi = task & 4095, bh = task >> 12, b = bh >> 3, h = bh & 7; const size_t row = (size_t)b * SEQ + qi;
        u32x4 qv[12];
#pragma unroll
        for (int i = 0; i < 12; ++i) qv[i] = *(const u32x4*)(Q + row * 768 + h * 96 + 8 * i);
        float mi = -INFINITY, l = 0.f, o[64];
#pragma unroll
        for (int d = 0; d < 64; ++d) o[d] = 0.f;
        for (int k = lane; k <= qi; k += 64) {
            const size_t kr = (size_t)b * SEQ + k; float s = 0.f;
#pragma unroll
            for (int i = 0; i < 12; ++i) { const u32x4 kw = i < 8 ? *(const u32x4*)(KV + kr * 1024 + h * 64 + 8 * i) : *(const u32x4*)(KR + kr * 32 + 8 * (i - 8));
                float a[8], c[8]; unpack8(qv[i], a); unpack8(kw, c);
#pragma unroll
                for (int e = 0; e < 8; ++e) s += a[e] * c[e]; }
            const float mn = fmaxf(mi, s), al = __builtin_amdgcn_exp2f(mi - mn), pp = __builtin_amdgcn_exp2f(s - mn);
            l = l * al + pp; mi = mn;
#pragma unroll
            for (int i = 0; i < 8; ++i) { float c[8]; unpack8(*(const u32x4*)(KV + kr * 1024 + 512 + h * 64 + 8 * i), c);
#pragma unroll
                for (int e = 0; e < 8; ++e) o[8 * i + e] = o[8 * i + e] * al + pp * c[e]; }
        }
        const float mx = wave_max(mi); const float f = (mi == -INFINITY) ? 0.f : __builtin_amdgcn_exp2f(mi - mx);
        l = wave_sum(l * f); float mine = 0.f;
#pragma unroll
        for (int d = 0; d < 64; ++d) { const float t = wave_sum(o[d] * f); if (lane == d) mine = t; }
        PROJ[row * NPROJ + PC_ATT + h * 64 + lane] = f2bf(mine / l);
    }
}
DI float dot2f(unsigned a, unsigned b, float c) { return __builtin_amdgcn_fdot2_f32_bf16(__builtin_bit_cast(bf16x2_t, a), __builtin_bit_cast(bf16x2_t, b), c, false); }
DI void phase_attn_v2(const Frame& F) {
    LANE_IDS
    const bf16_t* Q = (const bf16_t*)(F.ws + WS_Q); const bf16_t* KV = (const bf16_t*)(F.ws + WS_KV); const bf16_t* KR = (const bf16_t*)(F.ws + WS_KR);
    bf16_t* PROJ = (bf16_t*)(F.ws + WS_PROJ);
    int z = 0; asm volatile("" : "+v"(z));
    for (int task = gw; task < 4096; task += F.NGW) {
        const int pass = task >> 11, w = task & 2047, bh = w & 63, r = w >> 6, qb = pass == 0 ? 63 - r : r, b = bh >> 3, h = bh & 7;
        const int q = qb * 64 + lane; const size_t row = (size_t)b * SEQ + q;
        unsigned qv[48];
#pragma unroll
        for (int i = 0; i < 12; ++i) { const u32x4 t = *(const u32x4*)(Q + row * 768 + h * 96 + 8 * i); qv[4 * i] = t.x; qv[4 * i + 1] = t.y; qv[4 * i + 2] = t.z; qv[4 * i + 3] = t.w; }
        float o[64], m = -1e30f, l = 0.f;
#pragma unroll
        for (int d = 0; d < 64; ++d) o[d] = 0.f;
        const int nkeys = qb * 64 + 64;
        for (int k0 = 0; k0 < nkeys; k0 += 4) {
            float sc[4];
#pragma unroll
            for (int j = 0; j < 4; ++j) {
                const size_t kr = (size_t)b * SEQ + k0 + j; float s0 = 0.f, s1 = 0.f;
                const u32x4* kp = (const u32x4*)(KV + kr * 1024 + h * 64) + z; const u32x4* rp = (const u32x4*)(KR + kr * 32) + z;
#pragma unroll
                for (int i = 0; i < 12; ++i) { const u32x4 t = i < 8 ? kp[i] : rp[i - 8];
                    s0 = dot2f(qv[4 * i], t.x, s0); s1 = dot2f(qv[4 * i + 1], t.y, s1); s0 = dot2f(qv[4 * i + 2], t.z, s0); s1 = dot2f(qv[4 * i + 3], t.w, s1); }
                sc[j] = (k0 + j <= q) ? s0 + s1 : -1e30f;
            }
            const float mn = fmaxf(fmaxf(fmaxf(sc[0], sc[1]), fmaxf(sc[2], sc[3])), m), al = __builtin_amdgcn_exp2f(m - mn);
            l *= al; m = mn;
#pragma unroll
            for (int d = 0; d < 64; ++d) o[d] *= al;
#pragma unroll
            for (int j = 0; j < 4; ++j) {
                const size_t kr = (size_t)b * SEQ + k0 + j; const float p = __builtin_amdgcn_exp2f(sc[j] - mn);
                const unsigned pa = pk2(p, 0.f), pb = pa << 16; l += bf2f((bf16_t)pa);
                const u32x4* vp = (const u32x4*)(KV + kr * 1024 + 512 + h * 64) + z;
#pragma unroll
                for (int i = 0; i < 8; ++i) { const u32x4 t = vp[i];
                    o[8 * i] = dot2f(pa, t.x, o[8 * i]); o[8 * i + 1] = dot2f(pb, t.x, o[8 * i + 1]); o[8 * i + 2] = dot2f(pa, t.y, o[8 * i + 2]); o[8 * i + 3] = dot2f(pb, t.y, o[8 * i + 3]);
                    o[8 * i + 4] = dot2f(pa, t.z, o[8 * i + 4]); o[8 * i + 5] = dot2f(pb, t.z, o[8 * i + 5]); o[8 * i + 6] = dot2f(pa, t.w, o[8 * i + 6]); o[8 * i + 7] = dot2f(pb, t.w, o[8 * i + 7]); }
            }
        }
        const float il = 1.0f / l;
#pragma unroll
        for (int i = 0; i < 8; ++i) { float v[8];
#pragma unroll
            for (int e = 0; e < 8; ++e) v[e] = o[8 * i + e] * il;
            *(u32x4*)(PROJ + row * NPROJ + PC_ATT + h * 64 + 8 * i) = pack8(v); }
    }
}
typedef float f32x16 __attribute__((ext_vector_type(16)));
DI int crow16(int r, int hi) { return (r & 3) + 8 * (r >> 2) + 4 * hi; }
constexpr int AT_K = 12288, AT_V = 8704, AT_VS = 136, AT_K0 = 0, AT_V0 = 2 * AT_K, AT_SCR = 2 * AT_K + 2 * AT_V;
DI void attn_unit(const Frame& F, int b, int h, int qb, int tid, int lane, int wave) {
    const bf16_t* Q = (const bf16_t*)(F.ws + WS_Q); const bf16_t* KV = (const bf16_t*)(F.ws + WS_KV); const bf16_t* KR = (const bf16_t*)(F.ws + WS_KR);
    bf16_t* PROJ = (bf16_t*)(F.ws + WS_PROJ);
    LAS unsigned char* lds = F.lds; LAS float* scr = (LAS float*)(lds + AT_SCR) + wave * 32;
    const int r32 = lane & 31, hi = lane >> 5;
    const size_t rowbase = (size_t)b * SEQ; const int q0 = qb * 256, qw = q0 + 32 * wave, myq = qw + r32;
    bf16x8 qr[6];
#pragma unroll
    for (int d0 = 0; d0 < 6; ++d0) qr[d0] = *(const bf16x8*)(Q + (rowbase + myq) * 768 + h * 96 + d0 * 16 + hi * 8);
    const int NT = (q0 + 256) / 64;
    const int kc0 = tid >> 6, krow = tid & 63, kc1 = kc0 + 8; const bool k2 = tid < 256;
    const int vrow = tid >> 3, vch = tid & 7;
    u32x4 kr0, kr1 = {0u, 0u, 0u, 0u}, vr;
#define AT_LOAD(t) do { const size_t kr_ = rowbase + (size_t)(t) * 64; \
        kr0 = *(const u32x4*)(KV + (kr_ + krow) * 1024 + h * 64 + 8 * kc0); \
        if (k2) kr1 = *(const u32x4*)(KR + (kr_ + krow) * 32 + 8 * (kc1 - 8)); \
        vr = *(const u32x4*)(KV + (kr_ + vrow) * 1024 + 512 + h * 64 + 8 * vch); } while (0)
#define AT_STORE(buf) do { LAS unsigned char* kb_ = lds + AT_K0 + (buf) * AT_K; LAS unsigned char* vb_ = lds + AT_V0 + (buf) * AT_V; \
        *(LAS u32x4*)(kb_ + kc0 * 1024 + krow * 16) = kr0; if (k2) *(LAS u32x4*)(kb_ + kc1 * 1024 + krow * 16) = kr1; \
        LAS bf16_t* vt_ = (LAS bf16_t*)(vb_ + vrow * 2); \
        vt_[(8 * vch + 0) * (AT_VS / 2)] = (bf16_t)(vr.x & 0xffffu); vt_[(8 * vch + 1) * (AT_VS / 2)] = (bf16_t)(vr.x >> 16); \
        vt_[(8 * vch + 2) * (AT_VS / 2)] = (bf16_t)(vr.y & 0xffffu); vt_[(8 * vch + 3) * (AT_VS / 2)] = (bf16_t)(vr.y >> 16); \
        vt_[(8 * vch + 4) * (AT_VS / 2)] = (bf16_t)(vr.z & 0xffffu); vt_[(8 * vch + 5) * (AT_VS / 2)] = (bf16_t)(vr.z >> 16); \
        vt_[(8 * vch + 6) * (AT_VS / 2)] = (bf16_t)(vr.w & 0xffffu); vt_[(8 * vch + 7) * (AT_VS / 2)] = (bf16_t)(vr.w >> 16); } while (0)
    AT_LOAD(0); AT_STORE(0);
    __syncthreads();
    f32x16 o0, o1, negm;
#pragma unroll
    for (int r = 0; r < 16; ++r) { o0[r] = 0.f; o1[r] = 0.f; negm[r] = 0.f; }
    float m = 0.f, l = 0.f;
    typedef float f32x2v __attribute__((ext_vector_type(2)));
    for (int t = 0; t < NT; ++t) {
        const int buf = t & 1;
        if (t + 1 < NT) AT_LOAD(t + 1);
        if (64 * t <= qw + 31) {
            const LAS unsigned char* kb = lds + AT_K0 + buf * AT_K + hi * 1024 + r32 * 16;
            f32x16 p0, p1;
            bf16x8 kf0[6], kf1[6];
#pragma unroll
            for (int d0 = 0; d0 < 6; ++d0) { kf0[d0] = *(const LAS bf16x8*)(kb + d0 * 2048); kf1[d0] = *(const LAS bf16x8*)(kb + d0 * 2048 + 512); }
            __builtin_amdgcn_s_setprio(1);
#pragma unroll
            for (int d0 = 0; d0 < 6; ++d0) {
                if (d0 == 0) { p0 = __builtin_amdgcn_mfma_f32_32x32x16_bf16(kf0[0], qr[0], negm, 0, 0, 0); p1 = __builtin_amdgcn_mfma_f32_32x32x16_bf16(kf1[0], qr[0], negm, 0, 0, 0); }
                else { p0 = __builtin_amdgcn_mfma_f32_32x32x16_bf16(kf0[d0], qr[d0], p0, 0, 0, 0); p1 = __builtin_amdgcn_mfma_f32_32x32x16_bf16(kf1[d0], qr[d0], p1, 0, 0, 0); }
            }
            __builtin_amdgcn_s_setprio(0);
            if (64 * t + 63 > qw) {
                const int kvb = 64 * t + 4 * hi;
#pragma unroll
                for (int r = 0; r < 16; ++r) { const int kv = kvb + (r & 3) + 8 * (r >> 2); if (kv > myq) p0[r] = -1e30f; if (kv + 32 > myq) p1[r] = -1e30f; }
            }
            float mx = fmaxf(fmaxf(p0[0], p1[0]), fmaxf(p0[1], p1[1]));
#pragma unroll
            for (int r = 2; r < 16; r += 2) mx = fmaxf(fmaxf(mx, fmaxf(fmaxf(p0[r], p1[r]), p0[r + 1])), p1[r + 1]);
            { auto rr_ = __builtin_amdgcn_permlane32_swap(__float_as_uint(mx), __float_as_uint(mx), false, false); mx = fmaxf(__uint_as_float(rr_[0]), __uint_as_float(rr_[1])); }
            const bool first = (t == 0);
            if (first || __any(mx > 8.0f)) {
                const float dl = first ? mx : fmaxf(mx, 0.f), al = first ? 0.f : __builtin_amdgcn_exp2f(-dl);
                m += dl;
#pragma unroll
                for (int r = 0; r < 16; ++r) { p0[r] -= dl; p1[r] -= dl; negm[r] = -m; }
                l *= al;
                if (hi == 0) scr[r32] = al;
                LDS_WAIT();
#pragma unroll
                for (int r = 0; r < 16; ++r) { const float a_ = scr[crow16(r, hi)]; o0[r] *= a_; o1[r] *= a_; }
            }
            f32x2v rs2 = {0.f, 0.f};
#pragma unroll
            for (int r = 0; r < 16; r += 2) { p0[r] = __builtin_amdgcn_exp2f(p0[r]); p0[r + 1] = __builtin_amdgcn_exp2f(p0[r + 1]); p1[r] = __builtin_amdgcn_exp2f(p1[r]); p1[r + 1] = __builtin_amdgcn_exp2f(p1[r + 1]);
                rs2 += (f32x2v){p0[r], p0[r + 1]}; rs2 += (f32x2v){p1[r], p1[r + 1]}; }
            float rs = rs2.x + rs2.y;
            { auto rr_ = __builtin_amdgcn_permlane32_swap(__float_as_uint(rs), __float_as_uint(rs), false, false); rs = __uint_as_float(rr_[0]) + __uint_as_float(rr_[1]); }
            l += rs;
            const LAS unsigned char* vb = lds + AT_V0 + buf * AT_V + r32 * AT_VS + 8 * hi;
            u32x4 vfa[4], vfb[4];
#pragma unroll
            for (int ks = 0; ks < 4; ++ks) { const int kvo = 32 * ks;
                const u32x2 a0 = *(const LAS u32x2*)(vb + kvo), a1 = *(const LAS u32x2*)(vb + kvo + 16);
                const u32x2 b0 = *(const LAS u32x2*)(vb + 32 * AT_VS + kvo), b1 = *(const LAS u32x2*)(vb + 32 * AT_VS + kvo + 16);
                vfa[ks] = (u32x4){a0.x, a0.y, a1.x, a1.y}; vfb[ks] = (u32x4){b0.x, b0.y, b1.x, b1.y}; }
            u32x4 pwv[4];
#pragma unroll
            for (int s2 = 0; s2 < 2; ++s2) {
                pwv[s2].x = pk2(p0[8 * s2], p0[8 * s2 + 1]); pwv[s2].y = pk2(p0[8 * s2 + 2], p0[8 * s2 + 3]); pwv[s2].z = pk2(p0[8 * s2 + 4], p0[8 * s2 + 5]); pwv[s2].w = pk2(p0[8 * s2 + 6], p0[8 * s2 + 7]);
                pwv[2 + s2].x = pk2(p1[8 * s2], p1[8 * s2 + 1]); pwv[2 + s2].y = pk2(p1[8 * s2 + 2], p1[8 * s2 + 3]); pwv[2 + s2].z = pk2(p1[8 * s2 + 4], p1[8 * s2 + 5]); pwv[2 + s2].w = pk2(p1[8 * s2 + 6], p1[8 * s2 + 7]); }
            __builtin_amdgcn_s_setprio(1);
#pragma unroll
            for (int ks = 0; ks < 4; ++ks) {
                const bf16x8 pa = __builtin_bit_cast(bf16x8, pwv[ks]);
                o0 = __builtin_amdgcn_mfma_f32_32x32x16_bf16(pa, __builtin_bit_cast(bf16x8, vfa[ks]), o0, 0, 0, 0);
                o1 = __builtin_amdgcn_mfma_f32_32x32x16_bf16(pa, __builtin_bit_cast(bf16x8, vfb[ks]), o1, 0, 0, 0);
            }
            __builtin_amdgcn_s_setprio(0);
        }
        if (t + 1 < NT) AT_STORE(buf ^ 1);
        __syncthreads();
    }
    if (hi == 0) scr[r32] = 1.0f / l;
    LDS_WAIT();
    {
        LAS bf16_t* stg = (LAS bf16_t*)(lds + AT_SCR + 1024 + wave * 4096);
#pragma unroll
        for (int r = 0; r < 16; ++r) { const int qi = crow16(r, hi); const float il = scr[qi];
            stg[qi * 64 + r32] = f2bf(o0[r] * il); stg[qi * 64 + 32 + r32] = f2bf(o1[r] * il); }
        LDS_WAIT();
#pragma unroll
        for (int i = 0; i < 4; ++i) { const int row = i * 8 + (lane >> 3), ch = lane & 7;
            const u32x4 v = *(const LAS u32x4*)(stg + row * 64 + ch * 8);
            *(u32x4*)(PROJ + (rowbase + qw + row) * NPROJ + PC_ATT + h * 64 + ch * 8) = v; }
    }
    __syncthreads();
#undef AT_LOAD
#undef AT_STORE
}
DI void phase_attn_mfma(const Frame& F) {
    LANE_IDS
    for (int p = blockIdx.x; p < 512; p += F.G) {
        const int bh = p & 63, s = p >> 6, b = bh >> 3, h = bh & 7;
        attn_unit(F, b, h, s, tid, lane, wave);
        attn_unit(F, b, h, 15 - s, tid, lane, wave);
    }
}
DI void phase_rows_mid(const Frame& F) {
    LANE_IDS
    const bf16_t* MO = (const bf16_t*)(F.ws + WS_HN); bf16_t* HN2 = (bf16_t*)(F.ws + WS_HN2); const float* gp = F.in[23];
    f32x4 gv[4];
#pragma unroll
    for (int j = 0; j < 4; ++j) gv[j] = *((const f32x4*)gp + lane + 64 * j);
    for (int m0 = gw * 2; m0 < M_TOK; m0 += F.NGW * 2) {
        f32x4 mv[2][4], xv[2][4]; float s1[2] = {0.f, 0.f}, s2[2] = {0.f, 0.f};
#pragma unroll
        for (int u = 0; u < 2; ++u) { const f32x4* xr = (const f32x4*)(F.in[0] + (size_t)(m0 + u) * DM) + lane; const u32x2* mr = (const u32x2*)(MO + (size_t)(m0 + u) * DM) + lane;
#pragma unroll
            for (int j = 0; j < 4; ++j) { const u32x2 w = mr[64 * j]; mv[u][j] = (f32x4){lo16(w.x), hi16(w.x), lo16(w.y), hi16(w.y)}; xv[u][j] = __builtin_nontemporal_load(xr + 64 * j); } }
#pragma unroll
        for (int u = 0; u < 2; ++u)
#pragma unroll
            for (int j = 0; j < 4; ++j) s1[u] += (mv[u][j][0] * mv[u][j][0] + mv[u][j][1] * mv[u][j][1]) + (mv[u][j][2] * mv[u][j][2] + mv[u][j][3] * mv[u][j][3]);
#pragma unroll
        for (int u = 0; u < 2; ++u) { const float r1 = rsqrtf(wave_sum(s1[u]) * (1.f / DM) + EPS);
#pragma unroll
            for (int j = 0; j < 4; ++j) { xv[u][j] = xv[u][j] + mv[u][j] * gv[j] * r1; s2[u] += (xv[u][j][0] * xv[u][j][0] + xv[u][j][1] * xv[u][j][1]) + (xv[u][j][2] * xv[u][j][2] + xv[u][j][3] * xv[u][j][3]); } }
#pragma unroll
        for (int u = 0; u < 2; ++u) { const float r2 = rsqrtf(wave_sum(s2[u]) * (1.f / DM) + EPS);
            u32x2* o = (u32x2*)(HN2 + (size_t)(m0 + u) * DM) + lane;
#pragma unroll
            for (int j = 0; j < 4; ++j) { u32x2 w; w.x = pk2(xv[u][j][0] * r2, xv[u][j][1] * r2); w.y = pk2(xv[u][j][2] * r2, xv[u][j][3] * r2); o[64 * j] = w; } }
    }
}
DI void phase_rows_out(const Frame& F) {
    LANE_IDS
    const bf16_t* MO = (const bf16_t*)(F.ws + WS_HN); const bf16_t* FFB = (const bf16_t*)(F.ws + WS_Q);
    f32x4 g1[4], g2[4];
#pragma unroll
    for (int j = 0; j < 4; ++j) { g1[j] = *((const f32x4*)F.in[23] + lane + 64 * j); g2[j] = *((const f32x4*)F.in[29] + lane + 64 * j); }
    for (int m0 = gw * 2; m0 < M_TOK; m0 += F.NGW * 2) {
        f32x4 mv[2][4], fv[2][4], xv[2][4]; float s1[2] = {0.f, 0.f}, s2[2] = {0.f, 0.f};
#pragma unroll
        for (int u = 0; u < 2; ++u) { const size_t m = (size_t)(m0 + u);
            const f32x4* xr = (const f32x4*)(F.in[0] + m * DM) + lane; const u32x2* mr = (const u32x2*)(MO + m * DM) + lane; const u32x2* fr_ = (const u32x2*)(FFB + m * DM) + lane;
#pragma unroll
            for (int j = 0; j < 4; ++j) { const u32x2 w = mr[64 * j], w2 = fr_[64 * j]; mv[u][j] = (f32x4){lo16(w.x), hi16(w.x), lo16(w.y), hi16(w.y)}; fv[u][j] = (f32x4){lo16(w2.x), hi16(w2.x), lo16(w2.y), hi16(w2.y)}; xv[u][j] = __builtin_nontemporal_load(xr + 64 * j); } }
#pragma unroll
        for (int u = 0; u < 2; ++u)
#pragma unroll
            for (int j = 0; j < 4; ++j) { s1[u] += (mv[u][j][0] * mv[u][j][0] + mv[u][j][1] * mv[u][j][1]) + (mv[u][j][2] * mv[u][j][2] + mv[u][j][3] * mv[u][j][3]);
                s2[u] += (fv[u][j][0] * fv[u][j][0] + fv[u][j][1] * fv[u][j][1]) + (fv[u][j][2] * fv[u][j][2] + fv[u][j][3] * fv[u][j][3]); }
#pragma unroll
        for (int u = 0; u < 2; ++u) { const float r1 = rsqrtf(wave_sum(s1[u]) * (1.f / DM) + EPS), r3 = rsqrtf(wave_sum(s2[u]) * (1.f / DM) + EPS);
            f32x4* o = (f32x4*)(F.out + (size_t)(m0 + u) * DM) + lane;
#pragma unroll
            for (int j = 0; j < 4; ++j) __builtin_nontemporal_store(xv[u][j] + mv[u][j] * g1[j] * r1 + fv[u][j] * g2[j] * r3, o + 64 * j); }
    }
}

typedef __attribute__((address_space(1))) unsigned gu32;
#define XB_TMO      128
#define XB_XCNT(j)  (256  + 64 * (j))
#define XB_XSUB(j)  (1280 + 64 * (j))
#define XB_XGEN(j)  (2304 + 64 * (j))
#define XB_TOP      3328
#define XB_TOPGEN   3392
#define XCD_BAR_WORDS 3456
#define XB_SPIN_CAP (1u << 18)

__device__ __forceinline__ unsigned xb_ld(unsigned* p)              { return __hip_atomic_load(p, __ATOMIC_RELAXED, __HIP_MEMORY_SCOPE_AGENT); }
__device__ __forceinline__ unsigned xb_add(unsigned* p, unsigned v) { return __hip_atomic_fetch_add(p, v, __ATOMIC_RELAXED, __HIP_MEMORY_SCOPE_AGENT); }
__device__ __forceinline__ unsigned xb_xcc_id() { return (unsigned)__builtin_amdgcn_s_getreg((3 << 11) | 20) & 0xFu; }
#define XB_SPIN(cond, bar) do { unsigned _sp = 0; while (cond) { __builtin_amdgcn_s_sleep(1); \
    if ((++_sp & 255u) == 0u) { if (xb_ld(&(bar)[XB_TMO])) break; if (_sp > XB_SPIN_CAP) { atomicAdd(&(bar)[XB_TMO], 1u); break; } } } } while (0)

struct XcdBarrier {
    unsigned* bar; unsigned x;
    volatile LAS unsigned* st;
};

__device__ __forceinline__ XcdBarrier xcd_barrier_post(unsigned* bar, volatile LAS unsigned* st) {
    XcdBarrier b; b.bar = bar; b.x = xb_xcc_id(); b.st = st;
    if (threadIdx.x == 0) (void)xb_add(&bar[XB_XCNT(b.x)], 1u);
    return b;
}
__device__ __forceinline__ void xcd_barrier_complete(unsigned* bar, unsigned x, unsigned& nloc, unsigned& nx) {
    const unsigned G = gridDim.x * gridDim.y * gridDim.z;
    unsigned sum, cnt, mine, sp = 0u;
    for (;;) {
        sum = 0u; cnt = 0u; mine = 0u;
#pragma unroll
        for (unsigned j = 0; j < 16; ++j) { const unsigned c = xb_ld(&bar[XB_XCNT(j)]); sum += c; cnt += (c > 0u) ? 1u : 0u; mine = (j == x) ? c : mine; }
        if (sum == G) break;
        __builtin_amdgcn_s_sleep(1);
        if ((++sp & 255u) == 0u) { if (xb_ld(&bar[XB_TMO])) break; if (sp > XB_SPIN_CAP) { atomicAdd(&bar[XB_TMO], 1u); break; } }
    }
    nloc = mine > 0u ? mine : 1u; nx = cnt > 0u ? cnt : 1u;
}

__device__ __forceinline__ void xcd_barrier(const XcdBarrier& b) {
    asm volatile("s_waitcnt vmcnt(0)" ::: "memory");
    __syncthreads();
    if (threadIdx.x == 0) {
        unsigned* bar = b.bar;
        __builtin_amdgcn_s_waitcnt(0);
        unsigned nloc = b.st[0], nx = b.st[1];
        if (nloc == 0u) { xcd_barrier_complete(bar, b.x, nloc, nx); b.st[0] = nloc; b.st[1] = nx; }
        const unsigned old = xb_add(&bar[XB_XSUB(b.x)], 1u);
        const unsigned gen = old / nloc;
        if (old + 1u == (gen + 1u) * nloc) {
            __builtin_amdgcn_fence(__ATOMIC_RELEASE, "agent");
            asm volatile("s_waitcnt vmcnt(0)" ::: "memory");
            const unsigned og = xb_add(&bar[XB_TOP], 1u);
            const unsigned tg = og / nx;
            if (og + 1u == (tg + 1u) * nx) xb_add(&bar[XB_TOPGEN], 1u);
            else XB_SPIN(xb_ld(&bar[XB_TOPGEN]) == tg, bar);
            __builtin_amdgcn_fence(__ATOMIC_ACQUIRE, "agent");
            xb_add(&bar[XB_XGEN(b.x)], 1u);
            asm volatile("s_waitcnt vmcnt(0)" ::: "memory");
        } else {
            XB_SPIN(xb_ld(&bar[XB_XGEN(b.x)]) == gen, bar);
            __builtin_amdgcn_fence(__ATOMIC_ACQUIRE, "agent");
            asm volatile("s_waitcnt vmcnt(0)" ::: "memory");
        }
    }
    __syncthreads();
}


DI void grid_bar(unsigned* ctr, unsigned target) {
    asm volatile("s_waitcnt vmcnt(0)" ::: "memory");
    __syncthreads();
    if (threadIdx.x == 0) {
        __builtin_amdgcn_fence(__ATOMIC_RELEASE, "");
        asm volatile("s_waitcnt vmcnt(0)" ::: "memory");
        __hip_atomic_fetch_add(ctr, 1u, __ATOMIC_RELAXED, __HIP_MEMORY_SCOPE_AGENT);
        unsigned spins = 0;
        while (__hip_atomic_load(ctr, __ATOMIC_RELAXED, __HIP_MEMORY_SCOPE_AGENT) < target) { __builtin_amdgcn_s_sleep(2); if (++spins > (1u << 26)) break; }
        __builtin_amdgcn_fence(__ATOMIC_ACQUIRE, "agent");
        asm volatile("s_waitcnt vmcnt(0)" ::: "memory");
    }
    __syncthreads();
}
#ifndef DIAG_STOP
#define DIAG_STOP 0
#endif
DI unsigned hash_region(const Frame& F, const unsigned char* base, size_t rows, size_t stride, size_t coff, size_t cbytes, unsigned salt) {
    LANE_IDS
    const size_t wpr = cbytes / 4, total = rows * wpr; unsigned h = 0;
    for (size_t idx = (size_t)gw * 64 + lane; idx < total; idx += (size_t)F.NGW * 64) {
        const size_t r = idx / wpr, c = idx % wpr; const unsigned w = *(const unsigned*)(base + r * stride + coff + c * 4);
        h += w * ((unsigned)idx * 2654435761u + salt);
    }
    return h;
}
#ifndef DIAG_AFTER
#define DIAG_AFTER -1
#endif
#ifndef DIAG_SEL
#define DIAG_SEL 8
#endif
DI void diag_hash(const Frame& F, unsigned* barw) {
    LANE_IDS
    unsigned h = 0; unsigned char* ws = F.ws;
    if (DIAG_SEL == 0) h += hash_region(F, ws + WS_Q, M_TOK, 2048, 0, 2048, 2);
    if (DIAG_SEL == 1) h += hash_region(F, ws + WS_YG, 1, 0, 0, 32 * MiB, 1);
    if (DIAG_SEL == 2) { h += hash_region(F, ws + WS_W, 1, 0, 0, W_END * 2, 1); }
    if (DIAG_SEL == 3) { h += hash_region(F, ws + WS_PROJ, M_TOK, 6656, 0, 2688 * 2, 1); h += hash_region(F, ws + WS_PROJ, M_TOK, 6656, 5376, 1024, 2); h += hash_region(F, ws + WS_UA, 65536, 768, 0, 768, 3); }
    if (DIAG_SEL == 8) { h += hash_region(F, ws + WS_PROJ, M_TOK, 6656, 0, 2688 * 2, 1); h += hash_region(F, ws + WS_UA, 65536, 768, 0, 512, 3); h += hash_region(F, ws + WS_SSQP, 1, 0, 0, (size_t)5 * M_TOK * 16, 4); }
    if (DIAG_SEL == 9) { h += hash_region(F, ws + WS_W, 1, 0, 0, W_BT1 * 2, 1); h += hash_region(F, ws + WS_HN, M_TOK, 2048, 0, 2048, 2); h += hash_region(F, ws + WS_COS, 1, 0, 0, 4 * MiB, 3); h += hash_region(F, ws + WS_TAB, 1, 0, 0, 540672, 4); }
    if (DIAG_SEL == 4) h += hash_region(F, ws + WS_SSMO, M_TOK, 1024, 0, 1024, 1);
    if (DIAG_SEL == 5) h += hash_region(F, ws + WS_HN2, M_TOK, 2048, 0, 2048, 1);
    if (DIAG_SEL == 6) h += hash_region(F, ws + WS_HN, M_TOK, 2048, 0, 2048, 1);
    if (DIAG_SEL == 7) h += hash_region(F, ws + WS_PROJ, M_TOK, 5632, 0, 5632, 1);
#pragma unroll
    for (int o = 1; o < 64; o <<= 1) h += __shfl_xor(h, o);
    if (lane == 0) atomicAdd(barw + 32, h);
}
DI void diag_write(const Frame& F, unsigned* barw) {
    LANE_IDS
    const unsigned H = __hip_atomic_load(barw + 32, __ATOMIC_RELAXED, __HIP_MEMORY_SCOPE_AGENT);
    for (size_t idx = (size_t)gw * 64 + lane; idx < (size_t)M_TOK * 1024; idx += (size_t)F.NGW * 64) F.out[idx] = (float)((H >> (idx & 15)) & 0xFFFFu);
}
#ifndef FLUSH_KB
#define FLUSH_KB 0
#endif
DI void flush_l2(const Frame& F) {
    if (FLUSH_KB == 0) return;
    const u32x4* src = (const u32x4*)(F.in[0]) + (size_t)blockIdx.x * (FLUSH_KB * 64) + tid_now();
    unsigned acc_ = 0;
#pragma unroll 8
    for (int i = 0; i < FLUSH_KB * 64 / 512; ++i) { const u32x4 w = __builtin_nontemporal_load(src + (size_t)i * 512); acc_ ^= w.x ^ w.y ^ w.z ^ w.w; }
    if (acc_ == 0x12345u) ((unsigned*)(F.ws + WS_BAR))[64 + (tid_now() & 63)] = acc_;
}
#ifndef PHMASK
#define PHMASK 0xFFFFFFFFu
#endif
#define PHON(k) ((PHMASK >> (k)) & 1u)
__global__ void __launch_bounds__(512, 2) mega_fwd(Params P) {
    extern __shared__ __attribute__((aligned(16))) unsigned char lds_raw[];
    cg::grid_group grid = cg::this_grid();
    Frame F;
    F.lds = (LAS unsigned char*)lds_raw;
    F.G = gridDim.x; F.NGW = F.G * 8;
#pragma unroll
    for (int i = 0; i < 30; ++i) F.in[i] = P.in[i];
    F.out = P.out; F.ws = P.ws;
    bf16_t* PROJ = (bf16_t*)(F.ws + WS_PROJ); bf16_t* UA = (bf16_t*)(F.ws + WS_UA); float* SSQP = (float*)(F.ws + WS_SSQP);
    const int bx = blockIdx.x, G = F.G;

    unsigned* barw = (unsigned*)(F.ws + WS_BAR);
    volatile LAS unsigned* xst = (volatile LAS unsigned*)(F.lds + LDS_BYTES - 64);
    if (threadIdx.x == 0) { xst[0] = 0u; xst[1] = 0u; }
    __syncthreads();
    XcdBarrier xbar = xcd_barrier_post(barw + 1024, xst);
    if (P.ph_hi - P.ph_lo > 1) grid.sync();
    unsigned nbar = 0;
    if (P.ph_lo <= 0 && 0 < P.ph_hi) {
    if (PHON(0)) phase0(F);
    }
    if (P.ph_lo <= 0 && 1 < P.ph_hi) { xcd_barrier(xbar); }
    if (P.ph_lo <= 1 && 1 < P.ph_hi) {
    if (PHON(1)) phase_ssm_mats(F);
    if (PHON(2)) { pg8::Gemm g{(const bf16_t*)(F.ws + WS_HN), F.wbf(W_IN), 1024, 1024, 1024, 0}; pg8::Order S; S.init(128, 13, G, bx);
      EpiProj E{PROJ, UA, SSQP, F.in[21]}; pg8::gemm_phase(F.lds, g, S, E); }
    }
    if (P.ph_lo <= 1 && 2 < P.ph_hi) { xcd_barrier(xbar); }
    if (P.ph_lo <= 2 && 2 < P.ph_hi) {
    if (PHON(3)) { phase_krope(F); phase_ssm_mats2(F); }
    if (PHON(4)) { pg8::Gemm g{PROJ + PC_CQ, F.wbf(W_UQ), NPROJ, 384, 384, 0}; pg8::Order S; S.init(128, 3, G, bx);
      EpiQ E{(bf16_t*)(F.ws + WS_Q), SSQP, (const float*)(F.ws + WS_COS), (const float*)(F.ws + WS_SIN), F.lds}; gemm_phase_drained(F.lds, g, S, E); }
    if (PHON(5)) { pg8::Gemm g{PROJ + PC_CKV, F.wbf(W_KV), NPROJ, 256, 256, 0}; pg8::Order S; S.init(128, 4, G, (bx + 128) % G);
      EpiKV E{(bf16_t*)(F.ws + WS_KV), SSQP}; pg8::gemm_phase(F.lds, g, S, E); }
    if (PHON(6) && bx >= G / 2) { pg8::Gemm g{UA, F.wbf(W_BT1), 384, 256, 256, 0}; pg8::Order S; S.init(256, 1, G - G / 2, bx - G / 2, 256, 0, 1);
      EpiS1 E{(float*)(F.ws + WS_HN)}; pg8::gemm_phase(F.lds, g, S, E); }
    }
    if (P.ph_lo <= 2 && 3 < P.ph_hi) { xcd_barrier(xbar); }
    if (P.ph_lo <= 3 && 3 < P.ph_hi) {
    if (PHON(7)) phase_scan(F);
    if (PHON(9)) { pg8::Gemm g{UA, F.wbf(W_BT3), 384, 384, 384, 0}; pg8::Order S; S.init(256, 1, G, bx, 256, 0, 1);
      EpiS3 E{(bf16_t*)(F.ws + WS_YG), UA, F.in[16], F.lds}; gemm_phase_drained(F.lds, g, S, E); }
    if (PHON(8)) phase_attn_mfma(F);
    }
    if (P.ph_lo <= 3 && 4 < P.ph_hi) { xcd_barrier(xbar); }
    if (P.ph_lo <= 4 && 4 < P.ph_hi) {
    if (PHON(11)) { pg8::Gemm g{(const bf16_t*)(F.ws + WS_YG), F.wbf(W_GLU), 16, 512, 512, (long)M_TOK * 16}; pg8::Order S; S.init(128, 2, G, bx);
      EpiGLU E{(const bf16_t*)(F.ws + WS_YG), (bf16_t*)(F.ws + WS_SSMO), F.in[18]}; pg8::gemm_phase(F.lds, g, S, E); }
    if (PHON(10)) { pg8::Gemm g{PROJ + PC_ATT, F.wbf(W_BA), NPROJ, 512, 512, 0}; pg8::Order S; S.init(128, 4, G, bx);
      EpiMerge<0> E{PROJ, (bf16_t*)(F.ws + WS_Q), (bf16_t*)(F.ws + WS_Q)}; pg8::gemm_phase(F.lds, g, S, E); }
    }
    if (P.ph_lo <= 4 && 5 < P.ph_hi) { xcd_barrier(xbar); }
    if (P.ph_lo <= 5 && 5 < P.ph_hi) {
    }
    if (P.ph_lo <= 6 && 6 < P.ph_hi) {
    if (PHON(12)) { pg8::Gemm g{(const bf16_t*)(F.ws + WS_SSMO), F.wbf(W_BS), 512, 512, 512, 0}; pg8::Order S; S.init(128, 4, G, bx);
      EpiMerge<1> E{PROJ, (bf16_t*)(F.ws + WS_Q), (bf16_t*)(F.ws + WS_HN2)}; pg8::gemm_phase(F.lds, g, S, E); }
    }
    if (P.ph_lo <= 6 && 7 < P.ph_hi) { xcd_barrier(xbar); }
    if (P.ph_lo <= 7 && 7 < P.ph_hi) {
    if (PHON(13)) { pg8::Gemm g{(const bf16_t*)(F.ws + WS_HN2), F.wbf(W_OUT), 1024, 1024, 1024, 0}; pg8::Order S; S.init(128, 4, G, bx);
      EpiStore E{(bf16_t*)(F.ws + WS_HN), 1024}; pg8::gemm_phase(F.lds, g, S, E); }
    }
    if (P.ph_lo <= 7 && 8 < P.ph_hi) { xcd_barrier(xbar); }
    if (P.ph_lo <= 8 && 8 < P.ph_hi) {
    if (PHON(14)) phase_rows_mid(F);
    }
    if (P.ph_lo <= 8 && 9 < P.ph_hi) { xcd_barrier(xbar); }
    if (P.ph_lo <= 9 && 9 < P.ph_hi) {
    if (PHON(15)) { pg8::Gemm g{(const bf16_t*)(F.ws + WS_HN2), F.wbf(W_UP), 1024, 1024, 1024, 0}; pg8::Order S; S.init(130, 22, G, bx, 254, -2, 0);
      EpiConv E{F.in[26], F.in[27], PROJ, F.lds};
      gemm_phase_drained(F.lds, g, S, E); }
    }
    if (P.ph_lo <= 9 && 10 < P.ph_hi) { xcd_barrier(xbar); }
    if (P.ph_lo <= 10 && 10 < P.ph_hi) {
    if (PHON(16)) { pg8::Gemm g{PROJ, F.wbf(W_DN), DFF, DFF, DFF, 0}; pg8::Order S; S.init(128, 4, G, bx);
      EpiStore E{(bf16_t*)(F.ws + WS_Q), 1024}; pg8::gemm_phase(F.lds, g, S, E); }
    }
    if (P.ph_lo <= 10 && 11 < P.ph_hi) { xcd_barrier(xbar); }
    if (P.ph_lo <= 11 && 11 < P.ph_hi) {
    if (PHON(17)) phase_rows_out(F);
    }
    if (P.ph_lo == 12) diag_hash(F, barw);
    if (P.ph_lo == 13) diag_write(F, barw);
}

extern "C" void kernel_launch(void* const* d_in, const int* in_sizes, int n_in, void* d_out, int out_size, void* d_ws, size_t ws_size, hipStream_t stream) {
    static int grid = 0;
    if (grid == 0) {
        if (n_in != 30 || ws_size < WS_NEED) { fprintf(stderr, "kernel_launch: unexpected n_in %d / ws %zu\n", n_in, ws_size); grid = -1; return; }
        int dev = 0, cus = 0, per_cu = 0;
        hipGetDevice(&dev); hipDeviceGetAttribute(&cus, hipDeviceAttributeMultiprocessorCount, dev);
        hipFuncSetAttribute((const void*)mega_fwd, hipFuncAttributeMaxDynamicSharedMemorySize, LDS_BYTES);
        hipOccupancyMaxActiveBlocksPerMultiprocessor(&per_cu, (const void*)mega_fwd, 512, LDS_BYTES);
        if (per_cu < 1) { fprintf(stderr, "kernel_launch: occupancy query says %d blocks/CU\n", per_cu); per_cu = 1; }
        grid = cus;
    }
    if (grid < 0) return;
    hipMemsetAsync((char*)d_ws + WS_BAR, 0, 32768, stream);
    Params p{};
    for (int i = 0; i < 30; ++i) p.in[i] = (const float*)d_in[i];
    p.out = (float*)d_out; p.ws = (unsigned char*)d_ws;
#if SINGLE_LAUNCH
    p.ph_lo = 0; p.ph_hi = 12;
    void* args[] = {&p};
    hipError_t e = hipLaunchCooperativeKernel((const void*)mega_fwd, dim3(grid), dim3(512), args, LDS_BYTES, stream);
#else
    hipError_t e = hipSuccess;
    const int nph = DIAG_AFTER >= 0 ? DIAG_AFTER + 1 : 12;
    for (int ph = 0; ph < nph; ++ph) { p.ph_lo = ph; p.ph_hi = ph + 1; hipLaunchKernelGGL(mega_fwd, dim3(grid), dim3(512), LDS_BYTES, stream, p); }
    if (DIAG_AFTER >= 0) for (int ph = 12; ph < 14; ++ph) { p.ph_lo = ph; p.ph_hi = ph + 1; hipLaunchKernelGGL(mega_fwd, dim3(grid), dim3(512), LDS_BYTES, stream, p); }
    e = hipGetLastError();
#endif
    if (e != hipSuccess) fprintf(stderr, "cooperative launch failed: %s (grid %d)\n", hipGetErrorString(e), grid);
}
```

```cpp
#include <hip/hip_runtime.h>
#include <hip/hip_cooperative_groups.h>
#include <cstdio>
#include <cstdint>
namespace cg = cooperative_groups;

#ifndef SINGLE_LAUNCH
#define SINGLE_LAUNCH 1
#endif
#ifndef NAIVE_GEMM
#define NAIVE_GEMM 0
#endif

typedef unsigned short bf16_t;
typedef short bf16x8 __attribute__((ext_vector_type(8)));
typedef float f32x4 __attribute__((ext_vector_type(4)));
typedef unsigned u32x4 __attribute__((ext_vector_type(4)));
typedef unsigned u32x2 __attribute__((ext_vector_type(2)));
#define LAS __attribute__((address_space(3)))
#define DI __device__ __forceinline__

constexpr int M_TOK = 32768, SEQ = 4096, NBATCH = 8, DM = 1024;
constexpr int NPROJ = 3328, D_IN = 3232;
constexpr int PC_GATE = 0, PC_CQ = 2048, PC_CKV = 2432, PC_U = 2688, PC_KR = 3200;
constexpr int PC_Y = 2048;
constexpr int PC_ATT = 2688;
constexpr int DFF = 2816;
constexpr float EPS = 1e-6f;
constexpr float QSCALE = 0.10206207261596575f * 1.4426950408889634f;

constexpr size_t MiB = 1u << 20;
constexpr size_t WS_W = 0;
constexpr size_t W_IN = 0, W_UQ = W_IN + (size_t)NPROJ * 1024, W_KV = W_UQ + 768 * 384, W_GLU = W_KV + 1024 * 256, W_BA = W_GLU + 512 * 512,
                 W_BS = W_BA + 1024 * 512, W_OUT = W_BS + 1024 * 512, W_UP = W_OUT + 1024 * 1024, W_DN = W_UP + (size_t)5632 * 1024,
                 W_BT1 = W_DN + (size_t)1024 * 2816, W_BT3 = W_BT1 + (size_t)32 * 256 * 256, W_END = W_BT3 + (size_t)32 * 256 * 384;
static_assert(W_END * 2 <= 40 * MiB, "weights region");
constexpr size_t WS_COS = 40 * MiB, WS_SIN = 42 * MiB, WS_SSQP = 44 * MiB;
constexpr size_t WS_HN = 48 * MiB;
constexpr size_t WS_YG = 80 * MiB;
constexpr size_t WS_PROJ = 112 * MiB;
constexpr size_t WS_Q = 320 * MiB;
constexpr size_t WS_KV = 368 * MiB;
constexpr size_t WS_SSMO = 384 * MiB;
constexpr size_t WS_HN2 = 416 * MiB + 8192;
constexpr size_t WS_KR = 432 * MiB;
constexpr size_t WS_UA = 434 * MiB;
constexpr size_t WS_TAB = 484 * MiB;
constexpr size_t WS_BAR = 487 * MiB;
constexpr size_t WS_NEED = 488 * MiB;

constexpr int LDS_RING = 131072, LDS_BYTES = 147456;

struct Params { const float* in[30]; float* out; unsigned char* ws; int ph_lo, ph_hi; };

DI float bf2f(bf16_t v) { return __uint_as_float((unsigned)v << 16); }
DI bf16_t f2bf(float f) { unsigned u = __float_as_uint(f); return (bf16_t)((u + 0x7fffu + ((u >> 16) & 1u)) >> 16); }
typedef float f32x2_t __attribute__((ext_vector_type(2))); typedef __bf16 bf16x2_t __attribute__((ext_vector_type(2)));
DI unsigned pk2(float lo, float hi) { f32x2_t v = {lo, hi}; bf16x2_t b = __builtin_convertvector(v, bf16x2_t); return __builtin_bit_cast(unsigned, b); }
DI float lo16(unsigned u) { return __uint_as_float(u << 16); }
DI float hi16(unsigned u) { return __uint_as_float(u & 0xffff0000u); }
DI void unpack8(const u32x4& w, float (&v)[8]) { v[0] = lo16(w.x); v[1] = hi16(w.x); v[2] = lo16(w.y); v[3] = hi16(w.y); v[4] = lo16(w.z); v[5] = hi16(w.z); v[6] = lo16(w.w); v[7] = hi16(w.w); }
DI u32x4 pack8(const float (&v)[8]) { u32x4 w; w.x = pk2(v[0], v[1]); w.y = pk2(v[2], v[3]); w.z = pk2(v[4], v[5]); w.w = pk2(v[6], v[7]); return w; }
DI float gelu_t(float x) { const float u = x * (1.0f + 0.044715f * x * x); const float e = __builtin_amdgcn_exp2f(-2.3022082f * u); return x * __builtin_amdgcn_rcpf(1.0f + e); }
DI float sigmoid_f(float z) { return __builtin_amdgcn_rcpf(1.0f + __builtin_amdgcn_exp2f(-1.4426950408889634f * z)); }
DI float wave_sum(float v) {
#pragma unroll
    for (int o = 1; o < 64; o <<= 1) v += __shfl_xor(v, o);
    return v;
}
DI float wave_max(float v) {
#pragma unroll
    for (int o = 1; o < 64; o <<= 1) v = fmaxf(v, __shfl_xor(v, o));
    return v;
}
#define LDS_WAIT() asm volatile("s_waitcnt lgkmcnt(0)" ::: "memory")
DI int tid_now() { int t = threadIdx.x; asm volatile("" : "+v"(t)); return t; }

namespace pg8 {
constexpr int BM = 256, BK = 64, HALF = 128, HTB = HALF * BK * 2, NXCD = 8, WGM = 8;
__host__ __device__ __forceinline__ int lds_byte(int r, int c) { const int st = (r >> 4) * 2 + (c >> 5), rr = r & 15, cc = c & 31, ob = rr * 64 + cc * 2; return st * 1024 + (ob ^ (((ob >> 9) & 1) << 5)); }
__host__ __device__ __forceinline__ void stage_rc(int b, int& R, int& C) { const int st = b / 1024, sb = b % 1024, swz = sb ^ (((sb >> 9) & 1) << 5); R = (st >> 1) * 16 + swz / 64; C = (st & 1) * 32 + (swz % 64) / 2; }
__host__ __device__ __forceinline__ int perm32(int rho) { const int n = rho >> 4, i = rho & 15; return 8 * (i >> 2) + 4 * n + (i & 3); }

struct Unit { int pm, pn; };
struct Gemm { const bf16_t* A; const bf16_t* Bt; int lda, ldb, K; long agrp; };
struct Order {
    int nM, nN, nwg, G, c, amul, aoff, mode;
    DI void init(int nM_, int nN_, int G_, int c_, int amul_ = 256, int aoff_ = 0, int mode_ = 0) { nM = nM_; nN = nN_; nwg = nM * nN; G = G_; c = c_; amul = amul_; aoff = aoff_; mode = mode_; if (mode == 1) nwg = nM; }
    DI bool next(int i, Unit& u) const {
        const long L = (long)i * G + c; if (L >= nwg) return false;
        if (mode == 1) { u.pm = (int)L; u.pn = (int)L >> 3; return true; }
        if (mode == 2) { if (i > 0) return false; u.pm = nM; u.pn = nN; return true; }
        int wgid = (int)L; { const int q = nwg / NXCD, r = nwg % NXCD, xcd = wgid % NXCD, off = wgid / NXCD; wgid = (xcd < r ? xcd * (q + 1) : r * (q + 1) + (xcd - r) * q) + off; }
        const int nig = WGM * nN, gid = wgid / nig, fm = gid * WGM, gsz = (nM - fm) < WGM ? (nM - fm) : WGM;
        u.pm = fm + ((wgid % nig) % gsz); u.pn = (wgid % nig) / gsz; return true;
    }
    DI long arow(const Unit& u) const { return (long)u.pm * amul + aoff; }
    DI long brow(const Unit& u) const { return (long)u.pn * 256; }
};

typedef f32x4 Acc[2][2][4][2];

#if NAIVE_GEMM
template <class Epi, bool AFTER_DRAIN = false>
DI void gemm_phase(LAS unsigned char* lds, const Gemm g, const Order& S, const Epi& E) {
    const int tid = threadIdx.x, wid = tid >> 6, lane = tid & 63, wr = wid >> 2, wc = wid & 3, fr = lane & 15, fq = lane >> 4;
    Unit cur;
    for (int ui = 0; S.next(ui, cur); ++ui) {
        Acc acc;
#pragma unroll
        for (int a = 0; a < 2; ++a)
#pragma unroll
            for (int b = 0; b < 2; ++b)
#pragma unroll
                for (int m = 0; m < 4; ++m)
#pragma unroll
                    for (int n = 0; n < 2; ++n) acc[a][b][m][n] = (f32x4){0.f, 0.f, 0.f, 0.f};
        const bf16_t* Ab = g.A + S.arow(cur) * g.lda + (long)(64 * wr + fr) * g.lda;
        const bf16_t* Bb = g.Bt + S.brow(cur) * g.ldb + (long)(32 * wc + 8 * fq) * g.ldb;
        for (int k0 = 0; k0 < g.K; k0 += 8) {
#pragma unroll
            for (int a = 0; a < 2; ++a) {
                float av[4][8];
#pragma unroll
                for (int m = 0; m < 4; ++m) { const u32x4 w = *(const u32x4*)(Ab + (long)(128 * a + 16 * m) * g.lda + k0); unpack8(w, av[m]); }
#pragma unroll
                for (int b = 0; b < 2; ++b)
#pragma unroll
                    for (int n = 0; n < 2; ++n)
#pragma unroll
                        for (int j = 0; j < 4; ++j) {
                            const u32x4 w = *(const u32x4*)(Bb + (long)(128 * b + 4 * n + j) * g.ldb + k0); float bv[8]; unpack8(w, bv);
#pragma unroll
                            for (int m = 0; m < 4; ++m) { float s = acc[a][b][m][n][j];
#pragma unroll
                                for (int e = 0; e < 8; ++e) s += av[m][e] * bv[e];
                                acc[a][b][m][n][j] = s; }
                            asm volatile("" ::: "memory");
                        }
            }
        }
        if (AFTER_DRAIN) __syncthreads();
        E(acc, cur, wr, wc, fr, fq);
    }
    __syncthreads();
}
#else
template <class Epi, bool AFTER_DRAIN = false>
DI void gemm_phase(LAS unsigned char* lds, const Gemm g, const Order& S, const Epi& E) {
    const int tid = tid_now(), wid = __builtin_amdgcn_readfirstlane(tid >> 6), lane = tid & 63, wr = wid >> 2, wc = wid & 3, fr = lane & 15, fq = lane >> 4;
    int nt = g.K / BK; asm volatile("" : "+s"(nt));
    unsigned voffA[2], voffB[2];
#pragma unroll
    for (int i = 0; i < 2; ++i) { int R, C; stage_rc(tid * 16 + i * 8192, R, C); const int Rb = (R & ~31) + perm32(R & 31);
        voffA[i] = g.agrp ? (unsigned)((long)(C >> 4) * g.agrp + R * 16 + (C & 15)) * 2u : (unsigned)(R * g.lda + C) * 2u; voffB[i] = (unsigned)(Rb * g.ldb + C) * 2u; }
    const size_t kstep = (size_t)(BK * 2), kstepA = g.agrp ? (size_t)g.agrp * 8 : kstep;
    const size_t hstepA = (size_t)HALF * g.lda * 2, hstepB = (size_t)HALF * g.ldb * 2;
    const unsigned ldsw = (unsigned)wid * 1024u;
    const int aoff = lds_byte(wr * 64 + fr, fq * 8), boff = lds_byte(wc * 32 + fr, fq * 8);
#define PG8_SA(b, h) (((b) * 2 + (h)) * HTB)
#define PG8_SB(b, h) ((4 + (b) * 2 + (h)) * HTB)
#define PG8_STAGE(bufoff, gbase, voff) do { _Pragma("unroll") for (int _i = 0; _i < 2; ++_i) \
        __builtin_amdgcn_global_load_lds((const unsigned*)((const char*)(gbase) + (voff)[_i]), (LAS unsigned*)(lds + (bufoff) + ldsw + _i * 8192), 16, 0, 0); } while (0)
#define PG8_LDA(dst, b, h) do { _Pragma("unroll") for (int m = 0; m < 4; ++m) _Pragma("unroll") for (int k = 0; k < 2; ++k) dst[m][k] = *(const LAS bf16x8*)(lds + PG8_SA(b, h) + aoff + m * 2048 + k * 1024); } while (0)
#define PG8_LDB(dst, b, h) do { _Pragma("unroll") for (int n = 0; n < 2; ++n) _Pragma("unroll") for (int k = 0; k < 2; ++k) dst[n][k] = *(const LAS bf16x8*)(lds + PG8_SB(b, h) + boff + n * 2048 + k * 1024); } while (0)
#define PG8_MMA(ai, bj, At, Bt) do { __builtin_amdgcn_s_setprio(1); _Pragma("unroll") for (int m = 0; m < 4; ++m) _Pragma("unroll") for (int n = 0; n < 2; ++n) _Pragma("unroll") for (int k = 0; k < 2; ++k) \
        acc[ai][bj][m][n] = __builtin_amdgcn_mfma_f32_16x16x32_bf16(Bt[n][k], At[m][k], acc[ai][bj][m][n], 0, 0, 0); __builtin_amdgcn_s_setprio(0); } while (0)
#define PG8_WAIT_V(n) asm volatile("s_waitcnt vmcnt(" #n ")" ::: "memory")
#define PG8_WAIT_L(n) asm volatile("s_waitcnt lgkmcnt(" #n ")" ::: "memory")
#define PG8_BAR __builtin_amdgcn_s_barrier()
#define PG8_SCHED __builtin_amdgcn_sched_barrier(0)
    Unit cur, nxt; int ui = 0;
    if (!S.next(0, cur)) return;
    Acc acc;
#pragma unroll
    for (int a = 0; a < 2; ++a)
#pragma unroll
        for (int b = 0; b < 2; ++b)
#pragma unroll
            for (int m = 0; m < 4; ++m)
#pragma unroll
                for (int n = 0; n < 2; ++n) acc[a][b][m][n] = (f32x4){0.f, 0.f, 0.f, 0.f};
    bf16x8 At[4][2], B0[2][2], B1[2][2];
    const char* cA = (const char*)g.A + S.arow(cur) * (long)g.lda * 2; const char* cB = (const char*)g.Bt + S.brow(cur) * (long)g.ldb * 2;
    PG8_STAGE(PG8_SB(0, 0), cB, voffB); PG8_STAGE(PG8_SB(0, 1), cB + hstepB, voffB); PG8_STAGE(PG8_SA(0, 0), cA, voffA); PG8_STAGE(PG8_SA(0, 1), cA + hstepA, voffA);
    if (wr == 1) PG8_BAR;
    PG8_WAIT_V(2); PG8_BAR;
    PG8_STAGE(PG8_SB(1, 0), cB + kstep, voffB); PG8_STAGE(PG8_SA(1, 0), cA + kstepA, voffA); PG8_STAGE(PG8_SB(1, 1), cB + hstepB + kstep, voffB);
    PG8_WAIT_V(6); PG8_BAR;
    for (;;) {
        const bool has_next = S.next(ui + 1, nxt);
        const char* nA = has_next ? (const char*)g.A + S.arow(nxt) * (long)g.lda * 2 : cA; const char* nB = has_next ? (const char*)g.Bt + S.brow(nxt) * (long)g.ldb * 2 : cB;
#pragma unroll 1
        for (int t = 0; t < nt; t += 2) {
            const bool last = (t == nt - 2);
            const char* a1 = cA + (size_t)(t + 1) * kstepA;
            const char* a2 = last ? nA : cA + (size_t)(t + 2) * kstepA; const char* b2 = last ? nB : cB + (size_t)(t + 2) * kstep;
            const char* a3 = a2 + kstepA; const char* b3 = b2 + kstep;
            PG8_LDB(B0, 0, 0); PG8_LDB(B1, 0, 1); PG8_SCHED; PG8_LDA(At, 0, 0); PG8_STAGE(PG8_SA(1, 1), a1 + hstepA, voffA);
            PG8_WAIT_V(8); PG8_WAIT_L(0); PG8_BAR; PG8_MMA(0, 0, At, B0); PG8_MMA(0, 1, At, B1); PG8_BAR; PG8_SCHED;
            PG8_LDA(At, 0, 1); PG8_STAGE(PG8_SB(0, 0), b2, voffB); PG8_STAGE(PG8_SB(0, 1), b2 + hstepB, voffB); PG8_STAGE(PG8_SA(0, 0), a2, voffA);
            PG8_WAIT_V(8); PG8_WAIT_L(0); PG8_BAR; PG8_MMA(1, 0, At, B0); PG8_MMA(1, 1, At, B1); PG8_BAR; PG8_SCHED;
            PG8_LDB(B0, 1, 0); PG8_LDB(B1, 1, 1); PG8_SCHED; PG8_LDA(At, 1, 0); PG8_STAGE(PG8_SA(0, 1), a2 + hstepA, voffA);
            PG8_WAIT_V(8); PG8_WAIT_L(0); PG8_BAR; PG8_MMA(0, 0, At, B0); PG8_MMA(0, 1, At, B1); PG8_BAR; PG8_SCHED;
            PG8_LDA(At, 1, 1); PG8_STAGE(PG8_SB(1, 0), b3, voffB); PG8_STAGE(PG8_SB(1, 1), b3 + hstepB, voffB); PG8_STAGE(PG8_SA(1, 0), a3, voffA);
            PG8_WAIT_V(8); PG8_WAIT_L(0); PG8_BAR; PG8_MMA(1, 0, At, B0); PG8_MMA(1, 1, At, B1); PG8_BAR; PG8_SCHED;
        }
        if (wr == 0) PG8_BAR;
        if (!AFTER_DRAIN) E(acc, cur, wr, wc, fr, fq);
        if (!has_next) break;
#pragma unroll
        for (int a = 0; a < 2; ++a)
#pragma unroll
            for (int b = 0; b < 2; ++b)
#pragma unroll
                for (int m = 0; m < 4; ++m)
#pragma unroll
                    for (int n = 0; n < 2; ++n) acc[a][b][m][n] = (f32x4){0.f, 0.f, 0.f, 0.f};
        cur = nxt; cA = nA; cB = nB; ++ui;
        if (wr == 1) PG8_BAR;
    }
    PG8_WAIT_V(0);
    PG8_BAR;
    if (AFTER_DRAIN) E(acc, cur, wr, wc, fr, fq);
#undef PG8_SA
#undef PG8_SB
#undef PG8_STAGE
#undef PG8_LDA
#undef PG8_LDB
#undef PG8_MMA
#undef PG8_WAIT_V
#undef PG8_WAIT_L
#undef PG8_BAR
#undef PG8_SCHED
}
#endif
}
using pg8::Unit; using pg8::Acc;
template <class Epi> DI void gemm_phase_drained(LAS unsigned char* lds, const pg8::Gemm g, const pg8::Order& S, const Epi& E) {
    pg8::Unit un;
    for (int i = 0; S.next(i, un); ++i) { pg8::Order S1 = S; S1.mode = 2; S1.nM = un.pm; S1.nN = un.pn; S1.nwg = 1; S1.c = 0; pg8::gemm_phase<Epi, true>(lds, g, S1, E); }
}

#define EPI_ROWS(ai, m) (128 * (ai) + 64 * wr + 16 * (m) + fr)
DI void acc8(const Acc& acc, int ai, int bj, int m, float (&v)[8]) {
    v[0] = acc[ai][bj][m][0][0]; v[1] = acc[ai][bj][m][0][1]; v[2] = acc[ai][bj][m][0][2]; v[3] = acc[ai][bj][m][0][3];
    v[4] = acc[ai][bj][m][1][0]; v[5] = acc[ai][bj][m][1][1]; v[6] = acc[ai][bj][m][1][2]; v[7] = acc[ai][bj][m][1][3];
}
DI void ld8f(const float* p, float (&v)[8]) { const f32x4 a = *(const f32x4*)p, b = *(const f32x4*)(p + 4); v[0] = a[0]; v[1] = a[1]; v[2] = a[2]; v[3] = a[3]; v[4] = b[0]; v[5] = b[1]; v[6] = b[2]; v[7] = b[3]; }

constexpr int CT_STRIDE = 528;
DI void stage_acc_lds(const Acc& acc, LAS unsigned char* lds, int wr, int wc) {
    int t_ = threadIdx.x; asm volatile("" : "+v"(t_)); const int fr = t_ & 15, fq = (t_ >> 4) & 3;
#pragma unroll
    for (int ai = 0; ai < 2; ++ai)
#pragma unroll
        for (int m = 0; m < 4; ++m)
#pragma unroll
            for (int bj = 0; bj < 2; ++bj) { float v[8]; acc8(acc, ai, bj, m, v);
                *(LAS u32x4*)(lds + EPI_ROWS(ai, m) * CT_STRIDE + (bj * 128 + wc * 32 + 8 * fq) * 2) = pack8(v); }
    LDS_WAIT(); __builtin_amdgcn_s_barrier(); asm volatile("" ::: "memory");
}
DI void lds_ld8(const LAS unsigned char* p, float (&v)[8]) { const u32x4 w_ = *(const LAS u32x4*)p; unpack8(w_, v); }
struct EpiProj {
    bf16_t* proj; bf16_t* ua; float* ssqp; const float* b_gate;
    DI void operator()(Acc& acc, const Unit& u, int wr, int wc, int fr, int fq) const {
        { int t_ = threadIdx.x; asm volatile("" : "+v"(t_)); fr = t_ & 15; fq = (t_ >> 4) & 3; }
#pragma unroll
        for (int bj = 0; bj < 2; ++bj) {
            const int seg = 2 * u.pn + bj, col = seg * 128 + wc * 32 + 8 * fq;
            if (seg < 16) {
                float bv[8]; ld8f(b_gate + col, bv);
#pragma unroll
                for (int ai = 0; ai < 2; ++ai)
#pragma unroll
                    for (int m = 0; m < 4; ++m) { const int row = u.pm * 256 + EPI_ROWS(ai, m); float v[8]; acc8(acc, ai, bj, m, v);
#pragma unroll
                        for (int e = 0; e < 8; ++e) v[e] = sigmoid_f(v[e] + bv[e]);
                        *(u32x4*)(proj + (size_t)row * NPROJ + col) = pack8(v); asm volatile("" ::: "memory"); __builtin_amdgcn_sched_barrier(0); }
            } else if (seg < 21) {
#pragma unroll
                for (int ai = 0; ai < 2; ++ai)
#pragma unroll
                    for (int m = 0; m < 4; ++m) { const int row = u.pm * 256 + EPI_ROWS(ai, m); float v[8]; acc8(acc, ai, bj, m, v);
                        const u32x4 w = pack8(v); *(u32x4*)(proj + (size_t)row * NPROJ + col) = w;
                        float r[8]; unpack8(w, r); float s = 0.f;
#pragma unroll
                        for (int e = 0; e < 8; ++e) s += r[e] * r[e];
                        s += __shfl_xor(s, 16); s += __shfl_xor(s, 32);
                        if (fq == 0) ssqp[((size_t)(seg - 16) * M_TOK + row) * 4 + wc] = s; asm volatile("" ::: "memory"); __builtin_amdgcn_sched_barrier(0); }
            } else if (seg < 25) {
                const int cu = (seg - 21) * 128 + wc * 32 + 8 * fq, g = cu >> 4, h0 = cu & 15;
#pragma unroll
                for (int ai = 0; ai < 2; ++ai)
#pragma unroll
                    for (int m = 0; m < 4; ++m) { const int row = u.pm * 256 + EPI_ROWS(ai, m); float v[8]; acc8(acc, ai, bj, m, v);
                        const int b = row >> 12, t = row & 4095, c = t >> 4, t16 = t & 15;
                        *(u32x4*)(ua + ((size_t)((g * 8 + b) * 256 + c)) * 384 + t16 * 16 + h0) = pack8(v); asm volatile("" ::: "memory"); __builtin_amdgcn_sched_barrier(0); }
            } else if (wc == 0) {
#pragma unroll
                for (int ai = 0; ai < 2; ++ai)
#pragma unroll
                    for (int m = 0; m < 4; ++m) { const int row = u.pm * 256 + EPI_ROWS(ai, m); float v[8]; acc8(acc, ai, bj, m, v);
                        *(u32x4*)(proj + (size_t)row * NPROJ + col) = pack8(v); asm volatile("" ::: "memory"); __builtin_amdgcn_sched_barrier(0); }
            }
        }
    }
};
struct EpiQ {
    bf16_t* q; const float* ssqp; const float* cost; const float* sint; LAS unsigned char* lds;
    DI void operator()(Acc& acc, const Unit& u, int wr, int wc, int fr, int fq) const {
        stage_acc_lds(acc, lds, wr, wc);
        const int tid = threadIdx.x, cg = tid & 31, r0 = tid >> 5;
        const int gcol = u.pn * 256 + 8 * cg, d = gcol % 96;
        for (int it = 0; it < 16; ++it) {
            const int r = r0 + 16 * it; const size_t row = (size_t)u.pm * 256 + r;
            float ssq = 0.f;
#pragma unroll
            for (int i = 0; i < 3; ++i) { const f32x4 s0 = *(const f32x4*)(ssqp + ((size_t)i * M_TOK + row) * 4); ssq += (s0[0] + s0[1]) + (s0[2] + s0[3]); }
            const float sc = rsqrtf(ssq * (1.0f / 384.0f) + EPS) * QSCALE;
            float v[8]; lds_ld8(lds + r * CT_STRIDE + cg * 16, v);
            if (d >= 64) {
                const bool first = (d - 64) < 16; const int i0 = (d - 64) & 15;
                float p[8], cs[8], sn[8]; lds_ld8(lds + r * CT_STRIDE + (first ? cg + 2 : cg - 2) * 16, p);
                ld8f(cost + row * 16 + i0, cs); ld8f(sint + row * 16 + i0, sn);
#pragma unroll
                for (int e = 0; e < 8; ++e) v[e] = first ? v[e] * cs[e] - p[e] * sn[e] : v[e] * cs[e] + p[e] * sn[e];
            }
#pragma unroll
            for (int e = 0; e < 8; ++e) v[e] *= sc;
            *(u32x4*)(q + row * 768 + gcol) = pack8(v);
        }
        LDS_WAIT(); __builtin_amdgcn_s_barrier(); asm volatile("" ::: "memory");
    }
};
struct EpiKV {
    bf16_t* kv; const float* ssqp;
    DI void operator()(Acc& acc, const Unit& u, int wr, int wc, int fr, int fq) const {
        { int t_ = threadIdx.x; asm volatile("" : "+v"(t_)); fr = t_ & 15; fq = (t_ >> 4) & 3; }
#pragma unroll
        for (int ai = 0; ai < 2; ++ai)
#pragma unroll
            for (int m = 0; m < 4; ++m) {
                int row = u.pm * 256 + EPI_ROWS(ai, m); asm volatile("" : "+v"(row) :: "memory");
                const f32x4 s0 = *(const f32x4*)(ssqp + ((size_t)3 * M_TOK + row) * 4), s1 = *(const f32x4*)(ssqp + ((size_t)4 * M_TOK + row) * 4);
                const float ssq = ((s0[0] + s0[1]) + (s0[2] + s0[3])) + ((s1[0] + s1[1]) + (s1[2] + s1[3]));
                const float sc = rsqrtf(ssq * (1.0f / 256.0f) + EPS);
#pragma unroll
                for (int bj = 0; bj < 2; ++bj) { float v[8]; acc8(acc, ai, bj, m, v);
#pragma unroll
                    for (int e = 0; e < 8; ++e) v[e] *= sc;
                    *(u32x4*)(kv + (size_t)row * 1024 + u.pn * 256 + bj * 128 + wc * 32 + 8 * fq) = pack8(v); asm volatile("" ::: "memory"); __builtin_amdgcn_sched_barrier(0); }
            }
    }
};
struct EpiS1 {
    float* sl;
    DI void operator()(Acc& acc, const Unit& u, int wr, int wc, int fr, int fq) const {
        { int t_ = threadIdx.x; asm volatile("" : "+v"(t_)); fr = t_ & 15; fq = (t_ >> 4) & 3; }
#pragma unroll
        for (int ai = 0; ai < 2; ++ai)
#pragma unroll
            for (int m = 0; m < 4; ++m) { const int row = u.pm * 256 + EPI_ROWS(ai, m); float* p = sl + (size_t)row * 128 + wc * 32 + 8 * fq;
                *(f32x4*)p = acc[ai][0][m][0]; *(f32x4*)(p + 4) = acc[ai][0][m][1]; }
    }
};
struct EpiS3 {
    bf16_t* proj; const bf16_t* ua; const float* dskip; LAS unsigned char* lds;
    DI void operator()(Acc& acc, const Unit& u, int wr, int wc, int fr, int fq) const {
        stage_acc_lds(acc, lds, wr, wc);
        const int g = u.pm >> 3, b = u.pm & 7;
        const int tid = threadIdx.x, cg = tid & 31, r0 = tid >> 5, col = 8 * cg, t16 = col >> 4, h0 = col & 15;
        float dv[8]; ld8f(dskip + g * 16 + h0, dv);
        for (int it = 0; it < 16; ++it) {
            const int c = r0 + 16 * it; const size_t row = (size_t)u.pm * 256 + c;
            float v[8], uv[8]; lds_ld8(lds + c * CT_STRIDE + cg * 16, v); unpack8(*(const u32x4*)(ua + row * 384 + col), uv);
#pragma unroll
            for (int e = 0; e < 8; ++e) v[e] = gelu_t(v[e] + dv[e] * uv[e]);
            *(u32x4*)(proj + (((size_t)g * M_TOK + (size_t)b * 4096 + 16 * c + t16) * 16 + h0)) = pack8(v);
        }
        LDS_WAIT(); __builtin_amdgcn_s_barrier(); asm volatile("" ::: "memory");
    }
};
struct EpiGLU {
    const bf16_t* proj; bf16_t* ssmo; const float* b_glu;
    DI void operator()(Acc& acc, const Unit& u, int wr, int wc, int fr, int fq) const {
        { int t_ = threadIdx.x; asm volatile("" : "+v"(t_)); fr = t_ & 15; fq = (t_ >> 4) & 3; }
#pragma unroll
        for (int bj = 0; bj < 2; ++bj) {
            const int col = u.pn * 256 + bj * 128 + wc * 32 + 8 * fq; float bv[8]; ld8f(b_glu + col, bv);
#pragma unroll
            for (int ai = 0; ai < 2; ++ai)
#pragma unroll
                for (int m = 0; m < 4; ++m) { const size_t row = (size_t)u.pm * 256 + EPI_ROWS(ai, m); float v[8], y[8]; acc8(acc, ai, bj, m, v);
                    unpack8(*(const u32x4*)(proj + (((size_t)(col >> 4) * M_TOK + row) * 16 + (col & 15))), y);
#pragma unroll
                    for (int e = 0; e < 8; ++e) v[e] = y[e] * sigmoid_f(v[e] + bv[e]);
                    *(u32x4*)(ssmo + row * 512 + col) = pack8(v); asm volatile("" ::: "memory"); __builtin_amdgcn_sched_barrier(0); }
        }
    }
};
template <int SECOND> struct EpiMerge {
    const bf16_t* proj; bf16_t* merged; bf16_t* outp;
    DI void operator()(Acc& acc, const Unit& u, int wr, int wc, int fr, int fq) const {
        { int t_ = threadIdx.x; asm volatile("" : "+v"(t_)); fr = t_ & 15; fq = (t_ >> 4) & 3; }
#pragma unroll
        for (int bj = 0; bj < 2; ++bj) {
            const int col = u.pn * 256 + bj * 128 + wc * 32 + 8 * fq;
#pragma unroll
            for (int ai = 0; ai < 2; ++ai)
#pragma unroll
                for (int m = 0; m < 4; ++m) { const size_t row = (size_t)u.pm * 256 + EPI_ROWS(ai, m); float v[8], gt[8]; acc8(acc, ai, bj, m, v);
                    unpack8(*(const u32x4*)(proj + row * NPROJ + PC_GATE + SECOND * 1024 + col), gt);
                    if (SECOND) { float o[8]; unpack8(*(const u32x4*)(merged + row * 1024 + col), o);
#pragma unroll
                        for (int e = 0; e < 8; ++e) v[e] = o[e] + gt[e] * v[e]; }
                    else {
#pragma unroll
                        for (int e = 0; e < 8; ++e) v[e] = gt[e] * v[e]; }
                    *(u32x4*)(outp + row * 1024 + col) = pack8(v); asm volatile("" ::: "memory"); __builtin_amdgcn_sched_barrier(0); }
        }
    }
};
struct EpiStore {
    bf16_t* o; int ldc;
    DI void operator()(Acc& acc, const Unit& u, int wr, int wc, int fr, int fq) const {
        { int t_ = threadIdx.x; asm volatile("" : "+v"(t_)); fr = t_ & 15; fq = (t_ >> 4) & 3; }
#pragma unroll
        for (int bj = 0; bj < 2; ++bj) {
            const int col = u.pn * 256 + bj * 128 + wc * 32 + 8 * fq;
#pragma unroll
            for (int ai = 0; ai < 2; ++ai)
#pragma unroll
                for (int m = 0; m < 4; ++m) { const size_t row = (size_t)u.pm * 256 + EPI_ROWS(ai, m); float v[8]; acc8(acc, ai, bj, m, v); *(u32x4*)(o + row * ldc + col) = pack8(v); asm volatile("" ::: "memory"); __builtin_amdgcn_sched_barrier(0); }
        }
    }
};
struct EpiConv {
    const float* cw; const float* cb; bf16_t* abuf; LAS unsigned char* lds;
    DI void operator()(Acc& acc, const Unit& u, int wr, int wc, int fr, int fq) const {
        stage_acc_lds(acc, lds, wr, wc);
        const int tid = threadIdx.x, cg8 = (tid & 15) * 8, r0 = tid >> 4;
        const int R0 = 254 * u.pm - 2, gcol = 128 * u.pn + cg8;
        float w0[2][8], w1[2][8], w2[2][8], bb[2][8];
#pragma unroll
        for (int bj = 0; bj < 2; ++bj) { ld8f(cw + gcol + bj * DFF, w0[bj]); ld8f(cw + 2 * DFF + gcol + bj * DFF, w1[bj]); ld8f(cw + 4 * DFF + gcol + bj * DFF, w2[bj]); ld8f(cb + gcol + bj * DFF, bb[bj]); }
        for (int it = 0; it < 8; ++it) {
            const int r = r0 + 32 * it, R = R0 + r, t = R & 4095;
            if (r >= 2 && R < M_TOK) {
                float hc[2][8];
#pragma unroll
                for (int bj = 0; bj < 2; ++bj) {
                    float v[8], p1[8], p2[8];
                    { const u32x4 w_ = *(const LAS u32x4*)(lds + r * CT_STRIDE + (bj * 128 + cg8) * 2); unpack8(w_, v); }
                    { const u32x4 w_ = *(const LAS u32x4*)(lds + (r - 1) * CT_STRIDE + (bj * 128 + cg8) * 2); unpack8(w_, p1); }
                    { const u32x4 w_ = *(const LAS u32x4*)(lds + (r - 2) * CT_STRIDE + (bj * 128 + cg8) * 2); unpack8(w_, p2); }
#pragma unroll
                    for (int e = 0; e < 8; ++e) { const float q1 = t >= 1 ? p1[e] : 0.f, q2 = t >= 2 ? p2[e] : 0.f; hc[bj][e] = bb[bj][e] + w2[bj][e] * v[e] + w1[bj][e] * q1 + w0[bj][e] * q2; }
                }
                float o[8];
#pragma unroll
                for (int e = 0; e < 8; ++e) o[e] = gelu_t(hc[0][e]) * hc[1][e];
                *(u32x4*)(abuf + (size_t)R * DFF + gcol) = pack8(o);
            }
        }
        LDS_WAIT(); __builtin_amdgcn_s_barrier(); asm volatile("" ::: "memory");
    }
};

#define LANE_IDS const int tid = tid_now(), lane = tid & 63, wave = __builtin_amdgcn_readfirstlane(tid >> 6), gw = blockIdx.x * 8 + wave; (void)lane; (void)gw; (void)wave;
struct Frame {
    LAS unsigned char* lds; int G, NGW;
    const float* in[30]; float* out; unsigned char* ws;
    DI bf16_t* wbf(size_t eoff) const { return (bf16_t*)(ws + WS_W) + eoff; }
};

DI void tr_item(const float* W, int ldw, int ocol0, const float* gain, int k0, bf16_t* WT, int ldt, int n0, LAS float* scr, int lane) {
    { const int r8 = lane >> 3, c4 = (lane & 7) * 4;
#pragma unroll
      for (int i = 0; i < 8; ++i) { const int kk = 8 * i + r8; f32x4 v = {0.f, 0.f, 0.f, 0.f};
        if (ocol0 >= 0) { v = __builtin_nontemporal_load((const f32x4*)(W + (size_t)(k0 + kk) * ldw + ocol0 + c4)); if (gain) v *= gain[k0 + kk]; }
        LAS float* d = scr + kk * 33 + c4; d[0] = v[0]; d[1] = v[1]; d[2] = v[2]; d[3] = v[3]; } }
    LDS_WAIT(); asm volatile("" ::: "memory");
    const int c = lane & 7;
#pragma unroll
    for (int j = 0; j < 4; ++j) { const int n = (lane >> 3) + 8 * j; const LAS float* s = scr + (8 * c) * 33 + n;
        u32x4 o; o.x = pk2(s[0 * 33], s[1 * 33]); o.y = pk2(s[2 * 33], s[3 * 33]); o.z = pk2(s[4 * 33], s[5 * 33]); o.w = pk2(s[6 * 33], s[7 * 33]);
        *(u32x4*)(WT + (size_t)(n0 + n) * ldt + k0 + 8 * c) = o; }
    LDS_WAIT(); asm volatile("" ::: "memory");
}
DI int colmap(int mode, int n0) {
    if (mode == 0) return n0;
    if (mode == 1) { if (n0 < 2048) return 1184 + n0; if (n0 < 2432) return n0 - 2048; if (n0 < 2688) return 384 + (n0 - 2432); if (n0 < 3200) return 672 + (n0 - 2688); if (n0 < 3232) return 640 + (n0 - 3200); return -1; }
    const int tile = n0 >> 8, r = n0 & 255; return r < 128 ? 128 * tile + r : DFF + 128 * tile + (r - 128);
}
DI void prep_matrix(const Frame& F, const float* W, int ldw, int K, int Ndst, const float* gain, bf16_t* WT, int mode, LAS float* scr) {
    LANE_IDS
    const int nblk = Ndst / 32, items = (K / 64) * nblk;
    for (int it = gw; it < items; it += F.NGW) { const int kb = it / nblk, nb = it % nblk; tr_item(W, ldw, colmap(mode, 32 * nb), gain, 64 * kb, WT, K, 32 * nb, scr, lane); }
}

DI void phase0(const Frame& F) {
    LANE_IDS
    LAS float* scr = (LAS float*)(F.lds + wave * 16384);
    bf16_t* HN = (bf16_t*)(F.ws + WS_HN);
    for (int m0 = gw * 2; m0 < M_TOK; m0 += F.NGW * 2) {
        f32x4 v[2][4]; float sq[2] = {0.f, 0.f};
#pragma unroll
        for (int u = 0; u < 2; ++u) { const f32x4* xr = (const f32x4*)(F.in[0] + (size_t)(m0 + u) * DM) + lane;
#pragma unroll
            for (int j = 0; j < 4; ++j) v[u][j] = __builtin_nontemporal_load(xr + 64 * j); }
#pragma unroll
        for (int u = 0; u < 2; ++u)
#pragma unroll
            for (int j = 0; j < 4; ++j) sq[u] += (v[u][j][0] * v[u][j][0] + v[u][j][1] * v[u][j][1]) + (v[u][j][2] * v[u][j][2] + v[u][j][3] * v[u][j][3]);
#pragma unroll
        for (int u = 0; u < 2; ++u) { const float rstd = rsqrtf(wave_sum(sq[u]) * (1.f / DM) + EPS);
            u32x2* o = (u32x2*)(HN + (size_t)(m0 + u) * DM) + lane;
#pragma unroll
            for (int j = 0; j < 4; ++j) { u32x2 w; w.x = pk2(v[u][j][0] * rstd, v[u][j][1] * rstd); w.y = pk2(v[u][j][2] * rstd, v[u][j][3] * rstd); o[64 * j] = w; } }
    }
    {
        constexpr int I_IN = 16 * 104, I_UQ = 6 * 24, I_KV = 4 * 16, I_GLU = 8 * 16, I_B = 8 * 32, I_OUT = 16 * 32, I_UP = 16 * 176, I_DN = 44 * 32;
        constexpr int I_TOT = I_IN + I_UQ + 2 * I_KV + I_GLU + 2 * I_B + I_OUT + I_UP + I_DN;
#define PREP_ONE(W, ldw, K, Ndst, gain, WT, mode, cnt) if (r < (cnt)) { const int nblk_ = (Ndst) / 32, kb_ = r / nblk_, nb_ = r % nblk_; \
            tr_item(W, ldw, colmap(mode, 32 * nb_), gain, 64 * kb_, WT, K, 32 * nb_, scr, lane); continue; } r -= (cnt);
        for (int git = gw; git < I_TOT; git += F.NGW) {
            int r = git;
            PREP_ONE(F.in[25], 5632, 1024, 5632, F.in[24], F.wbf(W_UP), 2, I_UP)
            PREP_ONE(F.in[3], D_IN, 1024, NPROJ, F.in[2], F.wbf(W_IN), 1, I_IN)
            PREP_ONE(F.in[28], 1024, 2816, 1024, nullptr, F.wbf(W_DN), 0, I_DN)
            PREP_ONE(F.in[22], 1024, 1024, 1024, nullptr, F.wbf(W_OUT), 0, I_OUT)
            PREP_ONE(F.in[19], 1024, 512, 1024, nullptr, F.wbf(W_BA), 0, I_B)
            PREP_ONE(F.in[20], 1024, 512, 1024, nullptr, F.wbf(W_BS), 0, I_B)
            PREP_ONE(F.in[5], 768, 384, 768, F.in[4], F.wbf(W_UQ), 0, I_UQ)
            PREP_ONE(F.in[17], 512, 512, 512, nullptr, F.wbf(W_GLU), 0, I_GLU)
            PREP_ONE(F.in[7], 512, 256, 512, F.in[6], F.wbf(W_KV), 0, I_KV)
            PREP_ONE(F.in[8], 512, 256, 512, F.in[6], F.wbf(W_KV) + 512 * 256, 0, I_KV)
        }
#undef PREP_ONE
    }
    const int gt = gw * 64 + lane, NT = F.NGW * 64;
    float* COS = (float*)(F.ws + WS_COS); float* SIN = (float*)(F.ws + WS_SIN); const int* pos = (const int*)F.in[1];
    { const float invf = (float)exp2(-(double)(gt & 15) * (13.287712379549449 / 16.0));
      for (int idx = gt; idx < M_TOK * 16; idx += NT) { const float ang = (float)pos[idx >> 4] * invf; const double rev_ = (double)ang * 0.15915494309189535; const float fr_ = (float)(rev_ - rint(rev_));
        COS[idx] = __builtin_amdgcn_cosf(fr_); SIN[idx] = __builtin_amdgcn_sinf(fr_); } }
    float* APOW = (float*)(F.ws + WS_TAB); float* BBAR = APOW + 32 * 17 * 64 * 2;
    for (int it = NT - 1 - gt; it < 2048 * 17; it += NT) { const int idx = it & 2047, d = it >> 11, g = idx >> 6, p = idx & 63;
        const double dt = exp((double)F.in[11][g]), lr = F.in[9][idx], li = F.in[10][idx];
        const double mag = exp(lr * dt * d), ang = li * dt * d, cr = mag * cos(ang), ci = mag * sin(ang);
        APOW[((g * 17 + d) * 64 + p) * 2] = (float)cr; APOW[((g * 17 + d) * 64 + p) * 2 + 1] = (float)ci;
        if (d == 1) {
            const double den = lr * lr + li * li, nre = cr - 1.0, nim = ci, zre = (nre * lr + nim * li) / den, zim = (nim * lr - nre * li) / den;
            for (int h = 0; h < 16; ++h) { const double br = F.in[12][(size_t)idx * 16 + h], bi = F.in[13][(size_t)idx * 16 + h];
                BBAR[((size_t)idx * 16 + h) * 2] = (float)(zre * br - zim * bi); BBAR[((size_t)idx * 16 + h) * 2 + 1] = (float)(zre * bi + zim * br); } }
    }
}
DI void phase_ssm_mats(const Frame& F) {
    LANE_IDS
    const float* APOW = (const float*)(F.ws + WS_TAB); const float* BBAR = APOW + 32 * 17 * 64 * 2; float* KT = (float*)(F.ws + WS_TAB + 1 * MiB);
    const float* cre = F.in[14]; const float* cim = F.in[15];
    bf16_t* BT1 = F.wbf(W_BT1);
    const int gt = gw * 64 + lane, NT = F.NGW * 64;
    for (int idx = gt; idx < 32 * 256 * 256; idx += NT) { const int k = idx & 255, row = (idx >> 8) & 255, g = idx >> 16, j = k >> 4, hp = k & 15;
        float v = 0.f;
        if (row < 128) { const int p = row & 63; const float ar = APOW[((g * 17 + 15 - j) * 64 + p) * 2], ai = APOW[((g * 17 + 15 - j) * 64 + p) * 2 + 1];
            const float br = BBAR[((size_t)(g * 64 + p) * 16 + hp) * 2], bi = BBAR[((size_t)(g * 64 + p) * 16 + hp) * 2 + 1];
            v = row < 64 ? ar * br - ai * bi : ar * bi + ai * br; }
        BT1[idx] = f2bf(v); }
    for (int idx = gt; idx < 32 * 16 * 256; idx += NT) { const int hp = idx & 15, h = (idx >> 4) & 15, d = (idx >> 8) & 15, g = idx >> 12;
        float v = 0.f;
#pragma unroll 8
        for (int p = 0; p < 64; ++p) { const float ar = APOW[((g * 17 + d) * 64 + p) * 2], ai = APOW[((g * 17 + d) * 64 + p) * 2 + 1];
            const float br = BBAR[((size_t)(g * 64 + p) * 16 + hp) * 2], bi = BBAR[((size_t)(g * 64 + p) * 16 + hp) * 2 + 1];
            v += cre[(size_t)(g * 16 + h) * 64 + p] * (ar * br - ai * bi) - cim[(size_t)(g * 16 + h) * 64 + p] * (ar * bi + ai * br); }
        KT[idx] = v; }
}
DI void phase_ssm_mats2(const Frame& F) {
    LANE_IDS
    const float* APOW = (const float*)(F.ws + WS_TAB); const float* KT = (const float*)(F.ws + WS_TAB + 1 * MiB);
    const float* cre = F.in[14]; const float* cim = F.in[15];
    bf16_t* BT3 = F.wbf(W_BT3);
    const int gt = gw * 64 + lane, NT = F.NGW * 64;
    for (int item = gt; item < 32 * 256 * 48; item += NT) {
        const int k0 = 8 * (item % 48), row = (item / 48) & 255, g = item / (48 * 256), t = row >> 4, h = row & 15;
        float v[8];
#pragma unroll
        for (int e = 0; e < 8; ++e) v[e] = 0.f;
        if (k0 < 256) { const int j = k0 >> 4, hp0 = k0 & 15; if (j <= t) ld8f(KT + ((g * 16 + (t - j)) * 16 + h) * 16 + hp0, v); }
        else { const int p0 = (k0 - 256) & 63; float ap[16], cr[8], ci[8];
            ld8f(APOW + ((g * 17 + t + 1) * 64 + p0) * 2, *(float(*)[8])&ap[0]); ld8f(APOW + ((g * 17 + t + 1) * 64 + p0) * 2 + 8, *(float(*)[8])&ap[8]);
            ld8f(cre + (size_t)(g * 16 + h) * 64 + p0, cr); ld8f(cim + (size_t)(g * 16 + h) * 64 + p0, ci);
#pragma unroll
            for (int e = 0; e < 8; ++e) v[e] = k0 < 320 ? cr[e] * ap[2 * e] - ci[e] * ap[2 * e + 1] : -(cr[e] * ap[2 * e + 1] + ci[e] * ap[2 * e]); }
        *(u32x4*)(BT3 + (size_t)item * 8) = pack8(v);
    }
}
DI void phase_krope(const Frame& F) {
    LANE_IDS
    const bf16_t* PROJ = (const bf16_t*)(F.ws + WS_PROJ); bf16_t* KR = (bf16_t*)(F.ws + WS_KR);
    const float* COS = (const float*)(F.ws + WS_COS); const float* SIN = (const float*)(F.ws + WS_SIN);
    const int gt = gw * 64 + lane, NT = F.NGW * 64;
    for (int idx = gt; idx < M_TOK * 16; idx += NT) { const int m = idx >> 4, i = idx & 15;
        const float x1 = bf2f(PROJ[(size_t)m * NPROJ + PC_KR + i]), x2 = bf2f(PROJ[(size_t)m * NPROJ + PC_KR + 16 + i]), c = COS[idx], s = SIN[idx];
        KR[(size_t)m * 32 + i] = f2bf(x1 * c - x2 * s); KR[(size_t)m * 32 + 16 + i] = f2bf(x2 * c + x1 * s); }
}
DI void phase_scan(const Frame& F) {
    LANE_IDS
    const float* APOW = (const float*)(F.ws + WS_TAB); const float* SL = (const float*)(F.ws + WS_HN); bf16_t* UA = (bf16_t*)(F.ws + WS_UA);
    LAS float* ex = (LAS float*)F.lds;
    const int p = tid & 63, seg = tid >> 6;
    for (int item = blockIdx.x; item < 256; item += F.G) {
        const int g = item >> 3;
        const float a16r = APOW[((g * 17 + 16) * 64 + p) * 2], a16i = APOW[((g * 17 + 16) * 64 + p) * 2 + 1];
        const size_t row0 = (size_t)item * 256 + seg * 32;
        float sr = 0.f, si = 0.f;
#pragma unroll 16
        for (int i = 0; i < 32; ++i) { const float lr = SL[(row0 + i) * 128 + p], li = SL[(row0 + i) * 128 + 64 + p];
            const float nr = a16r * sr - a16i * si + lr, ni = a16r * si + a16i * sr + li; sr = nr; si = ni; }
        ex[(seg * 64 + p) * 2] = sr; ex[(seg * 64 + p) * 2 + 1] = si;
        __syncthreads();
        float pr = a16r, pi = a16i;
#pragma unroll
        for (int q = 0; q < 5; ++q) { const float nr = pr * pr - pi * pi, ni = 2.f * pr * pi; pr = nr; pi = ni; }
        float cr = 0.f, ci = 0.f;
        for (int s2 = 0; s2 < seg; ++s2) { const float er = ex[(s2 * 64 + p) * 2], ei = ex[(s2 * 64 + p) * 2 + 1];
            const float nr = pr * cr - pi * ci + er, ni = pr * ci + pi * cr + ei; cr = nr; ci = ni; }
        sr = cr; si = ci;
#pragma unroll 16
        for (int i = 0; i < 32; ++i) { UA[(row0 + i) * 384 + 256 + p] = f2bf(sr); UA[(row0 + i) * 384 + 320 + p] = f2bf(si);
            const float lr = SL[(row0 + i) * 128 + p], li = SL[(row0 + i) * 128 + 64 + p];
            const float nr = a16r * sr - a16i * si + lr, ni = a16r * si + a16i * sr + li; sr = nr; si = ni; }
        __syncthreads();
    }
}
DI void phase_attn_naive(const Frame& F) {
    LANE_IDS
    const bf16_t* Q = (const bf16_t*)(F.ws + WS_Q); const bf16_t* KV = (const bf16_t*)(F.ws + WS_KV); const bf16_t* KR = (const bf16_t*)(F.ws + WS_KR);
    bf16_t* PROJ = (bf16_t*)(F.ws + WS_PROJ);
    for (int task = gw; task < NBATCH * 8 * SEQ; task += F.NGW) {
        const int qi = task & 4095, bh = task >> 12, b = bh >> 3, h = bh & 7; const size_t row = (size_t)b * SEQ + qi;
        u32x4 qv[12];
#pragma unroll
        for (int i = 0; i < 12; ++i) qv[i] = *(const u32x4*)(Q + row * 768 + h * 96 + 8 * i);
        float mi = -INFINITY, l = 0.f, o[64];
#pragma unroll
        for (int d = 0; d < 64; ++d) o[d] = 0.f;
        for (int k = lane; k <= qi; k += 64) {
            const size_t kr = (size_t)b * SEQ + k; float s = 0.f;
#pragma unroll
            for (int i = 0; i < 12; ++i) { const u32x4 kw = i < 8 ? *(const u32x4*)(KV + kr * 1024 + h * 64 + 8 * i) : *(const u32x4*)(KR + kr * 32 + 8 * (i - 8));
                float a[8], c[8]; unpack8(qv[i], a); unpack8(kw, c);
#pragma unroll
                for (int e = 0; e < 8; ++e) s += a[e] * c[e]; }
            const float mn = fmaxf(mi, s), al = __builtin_amdgcn_exp2f(mi - mn), pp = __builtin_amdgcn_exp2f(s - mn);
            l = l * al + pp; mi = mn;
#pragma unroll
            for (int i = 0; i < 8; ++i) { float c[8]; unpack8(*(const u32x4*)(KV + kr * 1024 + 512 + h * 64 + 8 * i), c);
#pragma unroll
                for (int e = 0; e < 8; ++e) o[8 * i + e] = o[8 * i + e] * al + pp * c[e]; }
        }
        const float mx = wave_max(mi); const float f = (mi == -INFINITY) ? 0.f : __builtin_amdgcn_exp2f(mi - mx);
        l = wave_sum(l * f); float mine = 0.f;
#pragma unroll
        for (int d = 0; d < 64; ++d) { const float t = wave_sum(o[d] * f); if (lane == d) mine = t; }
        PROJ[row * NPROJ + PC_ATT + h * 64 + lane] = f2bf(mine / l);
    }
}
DI float dot2f(unsigned a, unsigned b, float c) { return __builtin_amdgcn_fdot2_f32_bf16(__builtin_bit_cast(bf16x2_t, a), __builtin_bit_cast(bf16x2_t, b), c, false); }
DI void phase_attn_v2(const Frame& F) {
    LANE_IDS
    const bf16_t* Q = (const bf16_t*)(F.ws + WS_Q); const bf16_t* KV = (const bf16_t*)(F.ws + WS_KV); const bf16_t* KR = (const bf16_t*)(F.ws + WS_KR);
    bf16_t* PROJ = (bf16_t*)(F.ws + WS_PROJ);
    int z = 0; asm volatile("" : "+v"(z));
    for (int task = gw; task < 4096; task += F.NGW) {
        const int pass = task >> 11, w = task & 2047, bh = w & 63, r = w >> 6, qb = pass == 0 ? 63 - r : r, b = bh >> 3, h = bh & 7;
        const int q = qb * 64 + lane; const size_t row = (size_t)b * SEQ + q;
        unsigned qv[48];
#pragma unroll
        for (int i = 0; i < 12; ++i) { const u32x4 t = *(const u32x4*)(Q + row * 768 + h * 96 + 8 * i); qv[4 * i] = t.x; qv[4 * i + 1] = t.y; qv[4 * i + 2] = t.z; qv[4 * i + 3] = t.w; }
        float o[64], m = -1e30f, l = 0.f;
#pragma unroll
        for (int d = 0; d < 64; ++d) o[d] = 0.f;
        const int nkeys = qb * 64 + 64;
        for (int k0 = 0; k0 < nkeys; k0 += 4) {
            float sc[4];
#pragma unroll
            for (int j = 0; j < 4; ++j) {
                const size_t kr = (size_t)b * SEQ + k0 + j; float s0 = 0.f, s1 = 0.f;
                const u32x4* kp = (const u32x4*)(KV + kr * 1024 + h * 64) + z; const u32x4* rp = (const u32x4*)(KR + kr * 32) + z;
#pragma unroll
                for (int i = 0; i < 12; ++i) { const u32x4 t = i < 8 ? kp[i] : rp[i - 8];
                    s0 = dot2f(qv[4 * i], t.x, s0); s1 = dot2f(qv[4 * i + 1], t.y, s1); s0 = dot2f(qv[4 * i + 2], t.z, s0); s1 = dot2f(qv[4 * i + 3], t.w, s1); }
                sc[j] = (k0 + j <= q) ? s0 + s1 : -1e30f;
            }
            const float mn = fmaxf(fmaxf(fmaxf(sc[0], sc[1]), fmaxf(sc[2], sc[3])), m), al = __builtin_amdgcn_exp2f(m - mn);
            l *= al; m = mn;
#pragma unroll
            for (int d = 0; d < 64; ++d) o[d] *= al;
#pragma unroll
            for (int j = 0; j < 4; ++j) {
                const size_t kr = (size_t)b * SEQ + k0 + j; const float p = __builtin_amdgcn_exp2f(sc[j] - mn);
                const unsigned pa = pk2(p, 0.f), pb = pa << 16; l += bf2f((bf16_t)pa);
                const u32x4* vp = (const u32x4*)(KV + kr * 1024 + 512 + h * 64) + z;
#pragma unroll
                for (int i = 0; i < 8; ++i) { const u32x4 t = vp[i];
                    o[8 * i] = dot2f(pa, t.x, o[8 * i]); o[8 * i + 1] = dot2f(pb, t.x, o[8 * i + 1]); o[8 * i + 2] = dot2f(pa, t.y, o[8 * i + 2]); o[8 * i + 3] = dot2f(pb, t.y, o[8 * i + 3]);
                    o[8 * i + 4] = dot2f(pa, t.z, o[8 * i + 4]); o[8 * i + 5] = dot2f(pb, t.z, o[8 * i + 5]); o[8 * i + 6] = dot2f(pa, t.w, o[8 * i + 6]); o[8 * i + 7] = dot2f(pb, t.w, o[8 * i + 7]); }
            }
        }
        const float il = 1.0f / l;
#pragma unroll
        for (int i = 0; i < 8; ++i) { float v[8];
#pragma unroll
            for (int e = 0; e < 8; ++e) v[e] = o[8 * i + e] * il;
            *(u32x4*)(PROJ + row * NPROJ + PC_ATT + h * 64 + 8 * i) = pack8(v); }
    }
}
typedef float f32x16 __attribute__((ext_vector_type(16)));
DI int crow16(int r, int hi) { return (r & 3) + 8 * (r >> 2) + 4 * hi; }
constexpr int AT_K = 12288, AT_V = 8704, AT_VS = 136, AT_K0 = 0, AT_V0 = 2 * AT_K, AT_SCR = 2 * AT_K + 2 * AT_V;
DI void attn_unit(const Frame& F, int b, int h, int qb, int tid, int lane, int wave) {
    const bf16_t* Q = (const bf16_t*)(F.ws + WS_Q); const bf16_t* KV = (const bf16_t*)(F.ws + WS_KV); const bf16_t* KR = (const bf16_t*)(F.ws + WS_KR);
    bf16_t* PROJ = (bf16_t*)(F.ws + WS_PROJ);
    LAS unsigned char* lds = F.lds; LAS float* scr = (LAS float*)(lds + AT_SCR) + wave * 32;
    const int r32 = lane & 31, hi = lane >> 5;
    const size_t rowbase = (size_t)b * SEQ; const int q0 = qb * 256, qw = q0 + 32 * wave, myq = qw + r32;
    bf16x8 qr[6];
#pragma unroll
    for (int d0 = 0; d0 < 6; ++d0) qr[d0] = *(const bf16x8*)(Q + (rowbase + myq) * 768 + h * 96 + d0 * 16 + hi * 8);
    const int NT = (q0 + 256) / 64;
    const int kc0 = tid >> 6, krow = tid & 63, kc1 = kc0 + 8; const bool k2 = tid < 256;
    const int vrow = tid >> 3, vch = tid & 7;
    u32x4 kr0, kr1 = {0u, 0u, 0u, 0u}, vr;
#define AT_LOAD(t) do { const size_t kr_ = rowbase + (size_t)(t) * 64; \
        kr0 = *(const u32x4*)(KV + (kr_ + krow) * 1024 + h * 64 + 8 * kc0); \
        if (k2) kr1 = *(const u32x4*)(KR + (kr_ + krow) * 32 + 8 * (kc1 - 8)); \
        vr = *(const u32x4*)(KV + (kr_ + vrow) * 1024 + 512 + h * 64 + 8 * vch); } while (0)
#define AT_STORE(buf) do { LAS unsigned char* kb_ = lds + AT_K0 + (buf) * AT_K; LAS unsigned char* vb_ = lds + AT_V0 + (buf) * AT_V; \
        *(LAS u32x4*)(kb_ + kc0 * 1024 + krow * 16) = kr0; if (k2) *(LAS u32x4*)(kb_ + kc1 * 1024 + krow * 16) = kr1; \
        LAS bf16_t* vt_ = (LAS bf16_t*)(vb_ + vrow * 2); \
        vt_[(8 * vch + 0) * (AT_VS / 2)] = (bf16_t)(vr.x & 0xffffu); vt_[(8 * vch + 1) * (AT_VS / 2)] = (bf16_t)(vr.x >> 16); \
        vt_[(8 * vch + 2) * (AT_VS / 2)] = (bf16_t)(vr.y & 0xffffu); vt_[(8 * vch + 3) * (AT_VS / 2)] = (bf16_t)(vr.y >> 16); \
        vt_[(8 * vch + 4) * (AT_VS / 2)] = (bf16_t)(vr.z & 0xffffu); vt_[(8 * vch + 5) * (AT_VS / 2)] = (bf16_t)(vr.z >> 16); \
        vt_[(8 * vch + 6) * (AT_VS / 2)] = (bf16_t)(vr.w & 0xffffu); vt_[(8 * vch + 7) * (AT_VS / 2)] = (bf16_t)(vr.w >> 16); } while (0)
    AT_LOAD(0); AT_STORE(0);
    __syncthreads();
    f32x16 o0, o1, negm;
#pragma unroll
    for (int r = 0; r < 16; ++r) { o0[r] = 0.f; o1[r] = 0.f; negm[r] = 0.f; }
    float m = 0.f, l = 0.f;
    typedef float f32x2v __attribute__((ext_vector_type(2)));
    for (int t = 0; t < NT; ++t) {
        const int buf = t & 1;
        if (t + 1 < NT) AT_LOAD(t + 1);
        if (64 * t <= qw + 31) {
            const LAS unsigned char* kb = lds + AT_K0 + buf * AT_K + hi * 1024 + r32 * 16;
            f32x16 p0, p1;
            bf16x8 kf0[6], kf1[6];
#pragma unroll
            for (int d0 = 0; d0 < 6; ++d0) { kf0[d0] = *(const LAS bf16x8*)(kb + d0 * 2048); kf1[d0] = *(const LAS bf16x8*)(kb + d0 * 2048 + 512); }
            __builtin_amdgcn_s_setprio(1);
#pragma unroll
            for (int d0 = 0; d0 < 6; ++d0) {
                if (d0 == 0) { p0 = __builtin_amdgcn_mfma_f32_32x32x16_bf16(kf0[0], qr[0], negm, 0, 0, 0); p1 = __builtin_amdgcn_mfma_f32_32x32x16_bf16(kf1[0], qr[0], negm, 0, 0, 0); }
                else { p0 = __builtin_amdgcn_mfma_f32_32x32x16_bf16(kf0[d0], qr[d0], p0, 0, 0, 0); p1 = __builtin_amdgcn_mfma_f32_32x32x16_bf16(kf1[d0], qr[d0], p1, 0, 0, 0); }
            }
            __builtin_amdgcn_s_setprio(0);
            if (64 * t + 63 > qw) {
                const int kvb = 64 * t + 4 * hi;
#pragma unroll
                for (int r = 0; r < 16; ++r) { const int kv = kvb + (r & 3) + 8 * (r >> 2); if (kv > myq) p0[r] = -1e30f; if (kv + 32 > myq) p1[r] = -1e30f; }
            }
            float mx = fmaxf(fmaxf(p0[0], p1[0]), fmaxf(p0[1], p1[1]));
#pragma unroll
            for (int r = 2; r < 16; r += 2) mx = fmaxf(fmaxf(mx, fmaxf(fmaxf(p0[r], p1[r]), p0[r + 1])), p1[r + 1]);
            { auto rr_ = __builtin_amdgcn_permlane32_swap(__float_as_uint(mx), __float_as_uint(mx), false, false); mx = fmaxf(__uint_as_float(rr_[0]), __uint_as_float(rr_[1])); }
            const bool first = (t == 0);
            if (first || __any(mx > 8.0f)) {
                const float dl = first ? mx : fmaxf(mx, 0.f), al = first ? 0.f : __builtin_amdgcn_exp2f(-dl);
                m += dl;
#pragma unroll
                for (int r = 0; r < 16; ++r) { p0[r] -= dl; p1[r] -= dl; negm[r] = -m; }
                l *= al;
                if (hi == 0) scr[r32] = al;
                LDS_WAIT();
#pragma unroll
                for (int r = 0; r < 16; ++r) { const float a_ = scr[crow16(r, hi)]; o0[r] *= a_; o1[r] *= a_; }
            }
            f32x2v rs2 = {0.f, 0.f};
#pragma unroll
            for (int r = 0; r < 16; r += 2) { p0[r] = __builtin_amdgcn_exp2f(p0[r]); p0[r + 1] = __builtin_amdgcn_exp2f(p0[r + 1]); p1[r] = __builtin_amdgcn_exp2f(p1[r]); p1[r + 1] = __builtin_amdgcn_exp2f(p1[r + 1]);
                rs2 += (f32x2v){p0[r], p0[r + 1]}; rs2 += (f32x2v){p1[r], p1[r + 1]}; }
            float rs = rs2.x + rs2.y;
            { auto rr_ = __builtin_amdgcn_permlane32_swap(__float_as_uint(rs), __float_as_uint(rs), false, false); rs = __uint_as_float(rr_[0]) + __uint_as_float(rr_[1]); }
            l += rs;
            const LAS unsigned char* vb = lds + AT_V0 + buf * AT_V + r32 * AT_VS + 8 * hi;
            u32x4 vfa[4], vfb[4];
#pragma unroll
            for (int ks = 0; ks < 4; ++ks) { const int kvo = 32 * ks;
                const u32x2 a0 = *(const LAS u32x2*)(vb + kvo), a1 = *(const LAS u32x2*)(vb + kvo + 16);
                const u32x2 b0 = *(const LAS u32x2*)(vb + 32 * AT_VS + kvo), b1 = *(const LAS u32x2*)(vb + 32 * AT_VS + kvo + 16);
                vfa[ks] = (u32x4){a0.x, a0.y, a1.x, a1.y}; vfb[ks] = (u32x4){b0.x, b0.y, b1.x, b1.y}; }
            u32x4 pwv[4];
#pragma unroll
            for (int s2 = 0; s2 < 2; ++s2) {
                pwv[s2].x = pk2(p0[8 * s2], p0[8 * s2 + 1]); pwv[s2].y = pk2(p0[8 * s2 + 2], p0[8 * s2 + 3]); pwv[s2].z = pk2(p0[8 * s2 + 4], p0[8 * s2 + 5]); pwv[s2].w = pk2(p0[8 * s2 + 6], p0[8 * s2 + 7]);
                pwv[2 + s2].x = pk2(p1[8 * s2], p1[8 * s2 + 1]); pwv[2 + s2].y = pk2(p1[8 * s2 + 2], p1[8 * s2 + 3]); pwv[2 + s2].z = pk2(p1[8 * s2 + 4], p1[8 * s2 + 5]); pwv[2 + s2].w = pk2(p1[8 * s2 + 6], p1[8 * s2 + 7]); }
            __builtin_amdgcn_s_setprio(1);
#pragma unroll
            for (int ks = 0; ks < 4; ++ks) {
                const bf16x8 pa = __builtin_bit_cast(bf16x8, pwv[ks]);
                o0 = __builtin_amdgcn_mfma_f32_32x32x16_bf16(pa, __builtin_bit_cast(bf16x8, vfa[ks]), o0, 0, 0, 0);
                o1 = __builtin_amdgcn_mfma_f32_32x32x16_bf16(pa, __builtin_bit_cast(bf16x8, vfb[ks]), o1, 0, 0, 0);
            }
            __builtin_amdgcn_s_setprio(0);
        }
        if (t + 1 < NT) AT_STORE(buf ^ 1);
        __syncthreads();
    }
    if (hi == 0) scr[r32] = 1.0f / l;
    LDS_WAIT();
#pragma unroll
    for (int r = 0; r < 16; ++r) { const int qi = crow16(r, hi); const float il = scr[qi];
        bf16_t* op = PROJ + (rowbase + qw + qi) * NPROJ + PC_ATT + h * 64 + r32;
        op[0] = f2bf(o0[r] * il); op[32] = f2bf(o1[r] * il); }
    __syncthreads();
#undef AT_LOAD
#undef AT_STORE
}
DI void phase_attn_mfma(const Frame& F) {
    LANE_IDS
    for (int p = blockIdx.x; p < 512; p += F.G) {
        const int bh = p & 63, s = p >> 6, b = bh >> 3, h = bh & 7;
        attn_unit(F, b, h, s, tid, lane, wave);
        attn_unit(F, b, h, 15 - s, tid, lane, wave);
    }
}
DI void phase_rows_mid(const Frame& F) {
    LANE_IDS
    const bf16_t* MO = (const bf16_t*)(F.ws + WS_HN); bf16_t* HN2 = (bf16_t*)(F.ws + WS_HN2); const float* gp = F.in[23];
    f32x4 gv[4];
#pragma unroll
    for (int j = 0; j < 4; ++j) gv[j] = *((const f32x4*)gp + lane + 64 * j);
    for (int m0 = gw * 2; m0 < M_TOK; m0 += F.NGW * 2) {
        f32x4 mv[2][4], xv[2][4]; float s1[2] = {0.f, 0.f}, s2[2] = {0.f, 0.f};
#pragma unroll
        for (int u = 0; u < 2; ++u) { const f32x4* xr = (const f32x4*)(F.in[0] + (size_t)(m0 + u) * DM) + lane; const u32x2* mr = (const u32x2*)(MO + (size_t)(m0 + u) * DM) + lane;
#pragma unroll
            for (int j = 0; j < 4; ++j) { const u32x2 w = mr[64 * j]; mv[u][j] = (f32x4){lo16(w.x), hi16(w.x), lo16(w.y), hi16(w.y)}; xv[u][j] = __builtin_nontemporal_load(xr + 64 * j); } }
#pragma unroll
        for (int u = 0; u < 2; ++u)
#pragma unroll
            for (int j = 0; j < 4; ++j) s1[u] += (mv[u][j][0] * mv[u][j][0] + mv[u][j][1] * mv[u][j][1]) + (mv[u][j][2] * mv[u][j][2] + mv[u][j][3] * mv[u][j][3]);
#pragma unroll
        for (int u = 0; u < 2; ++u) { const float r1 = rsqrtf(wave_sum(s1[u]) * (1.f / DM) + EPS);
#pragma unroll
            for (int j = 0; j < 4; ++j) { xv[u][j] = xv[u][j] + mv[u][j] * gv[j] * r1; s2[u] += (xv[u][j][0] * xv[u][j][0] + xv[u][j][1] * xv[u][j][1]) + (xv[u][j][2] * xv[u][j][2] + xv[u][j][3] * xv[u][j][3]); } }
#pragma unroll
        for (int u = 0; u < 2; ++u) { const float r2 = rsqrtf(wave_sum(s2[u]) * (1.f / DM) + EPS);
            u32x2* o = (u32x2*)(HN2 + (size_t)(m0 + u) * DM) + lane;
#pragma unroll
            for (int j = 0; j < 4; ++j) { u32x2 w; w.x = pk2(xv[u][j][0] * r2, xv[u][j][1] * r2); w.y = pk2(xv[u][j][2] * r2, xv[u][j][3] * r2); o[64 * j] = w; } }
    }
}
DI void phase_rows_out(const Frame& F) {
    LANE_IDS
    const bf16_t* MO = (const bf16_t*)(F.ws + WS_HN); const bf16_t* FFB = (const bf16_t*)(F.ws + WS_Q);
    f32x4 g1[4], g2[4];
#pragma unroll
    for (int j = 0; j < 4; ++j) { g1[j] = *((const f32x4*)F.in[23] + lane + 64 * j); g2[j] = *((const f32x4*)F.in[29] + lane + 64 * j); }
    for (int m0 = gw * 2; m0 < M_TOK; m0 += F.NGW * 2) {
        f32x4 mv[2][4], fv[2][4], xv[2][4]; float s1[2] = {0.f, 0.f}, s2[2] = {0.f, 0.f};
#pragma unroll
        for (int u = 0; u < 2; ++u) { const size_t m = (size_t)(m0 + u);
            const f32x4* xr = (const f32x4*)(F.in[0] + m * DM) + lane; const u32x2* mr = (const u32x2*)(MO + m * DM) + lane; const u32x2* fr_ = (const u32x2*)(FFB + m * DM) + lane;
#pragma unroll
            for (int j = 0; j < 4; ++j) { const u32x2 w = mr[64 * j], w2 = fr_[64 * j]; mv[u][j] = (f32x4){lo16(w.x), hi16(w.x), lo16(w.y), hi16(w.y)}; fv[u][j] = (f32x4){lo16(w2.x), hi16(w2.x), lo16(w2.y), hi16(w2.y)}; xv[u][j] = __builtin_nontemporal_load(xr + 64 * j); } }
#pragma unroll
        for (int u = 0; u < 2; ++u)
#pragma unroll
            for (int j = 0; j < 4; ++j) { s1[u] += (mv[u][j][0] * mv[u][j][0] + mv[u][j][1] * mv[u][j][1]) + (mv[u][j][2] * mv[u][j][2] + mv[u][j][3] * mv[u][j][3]);
                s2[u] += (fv[u][j][0] * fv[u][j][0] + fv[u][j][1] * fv[u][j][1]) + (fv[u][j][2] * fv[u][j][2] + fv[u][j][3] * fv[u][j][3]); }
#pragma unroll
        for (int u = 0; u < 2; ++u) { const float r1 = rsqrtf(wave_sum(s1[u]) * (1.f / DM) + EPS), r3 = rsqrtf(wave_sum(s2[u]) * (1.f / DM) + EPS);
            f32x4* o = (f32x4*)(F.out + (size_t)(m0 + u) * DM) + lane;
#pragma unroll
            for (int j = 0; j < 4; ++j) __builtin_nontemporal_store(xv[u][j] + mv[u][j] * g1[j] * r1 + fv[u][j] * g2[j] * r3, o + 64 * j); }
    }
}

typedef __attribute__((address_space(1))) unsigned gu32;
#define XB_TMO      128
#define XB_XCNT(j)  (256  + 64 * (j))
#define XB_XSUB(j)  (1280 + 64 * (j))
#define XB_XGEN(j)  (2304 + 64 * (j))
#define XB_TOP      3328
#define XB_TOPGEN   3392
#define XCD_BAR_WORDS 3456
#define XB_SPIN_CAP (1u << 18)

__device__ __forceinline__ unsigned xb_ld(unsigned* p)              { return __hip_atomic_load(p, __ATOMIC_RELAXED, __HIP_MEMORY_SCOPE_AGENT); }
__device__ __forceinline__ unsigned xb_add(unsigned* p, unsigned v) { return __hip_atomic_fetch_add(p, v, __ATOMIC_RELAXED, __HIP_MEMORY_SCOPE_AGENT); }
__device__ __forceinline__ unsigned xb_xcc_id() { return (unsigned)__builtin_amdgcn_s_getreg((3 << 11) | 20) & 0xFu; }
#define XB_SPIN(cond, bar) do { unsigned _sp = 0; while (cond) { __builtin_amdgcn_s_sleep(1); \
    if ((++_sp & 255u) == 0u) { if (xb_ld(&(bar)[XB_TMO])) break; if (_sp > XB_SPIN_CAP) { atomicAdd(&(bar)[XB_TMO], 1u); break; } } } } while (0)

struct XcdBarrier {
    unsigned* bar; unsigned x;
    volatile LAS unsigned* st;
};

__device__ __forceinline__ XcdBarrier xcd_barrier_post(unsigned* bar, volatile LAS unsigned* st) {
    XcdBarrier b; b.bar = bar; b.x = xb_xcc_id(); b.st = st;
    if (threadIdx.x == 0) (void)xb_add(&bar[XB_XCNT(b.x)], 1u);
    return b;
}
__device__ __forceinline__ void xcd_barrier_complete(unsigned* bar, unsigned x, unsigned& nloc, unsigned& nx) {
    const unsigned G = gridDim.x * gridDim.y * gridDim.z;
    unsigned sum, cnt, mine, sp = 0u;
    for (;;) {
        sum = 0u; cnt = 0u; mine = 0u;
#pragma unroll
        for (unsigned j = 0; j < 16; ++j) { const unsigned c = xb_ld(&bar[XB_XCNT(j)]); sum += c; cnt += (c > 0u) ? 1u : 0u; mine = (j == x) ? c : mine; }
        if (sum == G) break;
        __builtin_amdgcn_s_sleep(1);
        if ((++sp & 255u) == 0u) { if (xb_ld(&bar[XB_TMO])) break; if (sp > XB_SPIN_CAP) { atomicAdd(&bar[XB_TMO], 1u); break; } }
    }
    nloc = mine > 0u ? mine : 1u; nx = cnt > 0u ? cnt : 1u;
}

__device__ __forceinline__ void xcd_barrier(const XcdBarrier& b) {
    asm volatile("s_waitcnt vmcnt(0)" ::: "memory");
    __syncthreads();
    if (threadIdx.x == 0) {
        unsigned* bar = b.bar;
        __builtin_amdgcn_s_waitcnt(0);
        unsigned nloc = b.st[0], nx = b.st[1];
        if (nloc == 0u) { xcd_barrier_complete(bar, b.x, nloc, nx); b.st[0] = nloc; b.st[1] = nx; }
        const unsigned old = xb_add(&bar[XB_XSUB(b.x)], 1u);
        const unsigned gen = old / nloc;
        if (old + 1u == (gen + 1u) * nloc) {
            __builtin_amdgcn_fence(__ATOMIC_RELEASE, "agent");
            asm volatile("s_waitcnt vmcnt(0)" ::: "memory");
            const unsigned og = xb_add(&bar[XB_TOP], 1u);
            const unsigned tg = og / nx;
            if (og + 1u == (tg + 1u) * nx) xb_add(&bar[XB_TOPGEN], 1u);
            else XB_SPIN(xb_ld(&bar[XB_TOPGEN]) == tg, bar);
            __builtin_amdgcn_fence(__ATOMIC_ACQUIRE, "agent");
            xb_add(&bar[XB_XGEN(b.x)], 1u);
            asm volatile("s_waitcnt vmcnt(0)" ::: "memory");
        } else {
            XB_SPIN(xb_ld(&bar[XB_XGEN(b.x)]) == gen, bar);
            __builtin_amdgcn_fence(__ATOMIC_ACQUIRE, "agent");
            asm volatile("s_waitcnt vmcnt(0)" ::: "memory");
        }
    }
    __syncthreads();
}


DI void grid_bar(unsigned* ctr, unsigned target) {
    asm volatile("s_waitcnt vmcnt(0)" ::: "memory");
    __syncthreads();
    if (threadIdx.x == 0) {
        __builtin_amdgcn_fence(__ATOMIC_RELEASE, "");
        asm volatile("s_waitcnt vmcnt(0)" ::: "memory");
        __hip_atomic_fetch_add(ctr, 1u, __ATOMIC_RELAXED, __HIP_MEMORY_SCOPE_AGENT);
        unsigned spins = 0;
        while (__hip_atomic_load(ctr, __ATOMIC_RELAXED, __HIP_MEMORY_SCOPE_AGENT) < target) { __builtin_amdgcn_s_sleep(2); if (++spins > (1u << 26)) break; }
        __builtin_amdgcn_fence(__ATOMIC_ACQUIRE, "agent");
        asm volatile("s_waitcnt vmcnt(0)" ::: "memory");
    }
    __syncthreads();
}
#ifndef DIAG_STOP
#define DIAG_STOP 0
#endif
DI unsigned hash_region(const Frame& F, const unsigned char* base, size_t rows, size_t stride, size_t coff, size_t cbytes, unsigned salt) {
    LANE_IDS
    const size_t wpr = cbytes / 4, total = rows * wpr; unsigned h = 0;
    for (size_t idx = (size_t)gw * 64 + lane; idx < total; idx += (size_t)F.NGW * 64) {
        const size_t r = idx / wpr, c = idx % wpr; const unsigned w = *(const unsigned*)(base + r * stride + coff + c * 4);
        h += w * ((unsigned)idx * 2654435761u + salt);
    }
    return h;
}
#ifndef DIAG_AFTER
#define DIAG_AFTER -1
#endif
#ifndef DIAG_SEL
#define DIAG_SEL 8
#endif
DI void diag_hash(const Frame& F, unsigned* barw) {
    LANE_IDS
    unsigned h = 0; unsigned char* ws = F.ws;
    if (DIAG_SEL == 0) h += hash_region(F, ws + WS_Q, M_TOK, 2048, 0, 2048, 2);
    if (DIAG_SEL == 1) h += hash_region(F, ws + WS_YG, 1, 0, 0, 32 * MiB, 1);
    if (DIAG_SEL == 2) { h += hash_region(F, ws + WS_W, 1, 0, 0, W_END * 2, 1); }
    if (DIAG_SEL == 3) { h += hash_region(F, ws + WS_PROJ, M_TOK, 6656, 0, 2688 * 2, 1); h += hash_region(F, ws + WS_PROJ, M_TOK, 6656, 5376, 1024, 2); h += hash_region(F, ws + WS_UA, 65536, 768, 0, 768, 3); }
    if (DIAG_SEL == 8) { h += hash_region(F, ws + WS_PROJ, M_TOK, 6656, 0, 2688 * 2, 1); h += hash_region(F, ws + WS_UA, 65536, 768, 0, 512, 3); h += hash_region(F, ws + WS_SSQP, 1, 0, 0, (size_t)5 * M_TOK * 16, 4); }
    if (DIAG_SEL == 9) { h += hash_region(F, ws + WS_W, 1, 0, 0, W_BT1 * 2, 1); h += hash_region(F, ws + WS_HN, M_TOK, 2048, 0, 2048, 2); h += hash_region(F, ws + WS_COS, 1, 0, 0, 4 * MiB, 3); h += hash_region(F, ws + WS_TAB, 1, 0, 0, 540672, 4); }
    if (DIAG_SEL == 4) h += hash_region(F, ws + WS_SSMO, M_TOK, 1024, 0, 1024, 1);
    if (DIAG_SEL == 5) h += hash_region(F, ws + WS_HN2, M_TOK, 2048, 0, 2048, 1);
    if (DIAG_SEL == 6) h += hash_region(F, ws + WS_HN, M_TOK, 2048, 0, 2048, 1);
    if (DIAG_SEL == 7) h += hash_region(F, ws + WS_PROJ, M_TOK, 5632, 0, 5632, 1);
#pragma unroll
    for (int o = 1; o < 64; o <<= 1) h += __shfl_xor(h, o);
    if (lane == 0) atomicAdd(barw + 32, h);
}
DI void diag_write(const Frame& F, unsigned* barw) {
    LANE_IDS
    const unsigned H = __hip_atomic_load(barw + 32, __ATOMIC_RELAXED, __HIP_MEMORY_SCOPE_AGENT);
    for (size_t idx = (size_t)gw * 64 + lane; idx < (size_t)M_TOK * 1024; idx += (size_t)F.NGW * 64) F.out[idx] = (float)((H >> (idx & 15)) & 0xFFFFu);
}
#ifndef FLUSH_KB
#define FLUSH_KB 0
#endif
DI void flush_l2(const Frame& F) {
    if (FLUSH_KB == 0) return;
    const u32x4* src = (const u32x4*)(F.in[0]) + (size_t)blockIdx.x * (FLUSH_KB * 64) + tid_now();
    unsigned acc_ = 0;
#pragma unroll 8
    for (int i = 0; i < FLUSH_KB * 64 / 512; ++i) { const u32x4 w = __builtin_nontemporal_load(src + (size_t)i * 512); acc_ ^= w.x ^ w.y ^ w.z ^ w.w; }
    if (acc_ == 0x12345u) ((unsigned*)(F.ws + WS_BAR))[64 + (tid_now() & 63)] = acc_;
}
#ifndef PHMASK
#define PHMASK 0xFFFFFFFFu
#endif
#define PHON(k) ((PHMASK >> (k)) & 1u)
__global__ void __launch_bounds__(512, 2) mega_fwd(Params P) {
    extern __shared__ __attribute__((aligned(16))) unsigned char lds_raw[];
    cg::grid_group grid = cg::this_grid();
    Frame F;
    F.lds = (LAS unsigned char*)lds_raw;
    F.G = gridDim.x; F.NGW = F.G * 8;
#pragma unroll
    for (int i = 0; i < 30; ++i) F.in[i] = P.in[i];
    F.out = P.out; F.ws = P.ws;
    bf16_t* PROJ = (bf16_t*)(F.ws + WS_PROJ); bf16_t* UA = (bf16_t*)(F.ws + WS_UA); float* SSQP = (float*)(F.ws + WS_SSQP);
    const int bx = blockIdx.x, G = F.G;

    unsigned* barw = (unsigned*)(F.ws + WS_BAR);
    volatile LAS unsigned* xst = (volatile LAS unsigned*)(F.lds + LDS_BYTES - 64);
    if (threadIdx.x == 0) { xst[0] = 0u; xst[1] = 0u; }
    __syncthreads();
    XcdBarrier xbar = xcd_barrier_post(barw + 1024, xst);
    if (P.ph_hi - P.ph_lo > 1) grid.sync();
    unsigned nbar = 0;
    if (P.ph_lo <= 0 && 0 < P.ph_hi) {
    if (PHON(0)) phase0(F);
    }
    if (P.ph_lo <= 0 && 1 < P.ph_hi) { xcd_barrier(xbar); }
    if (P.ph_lo <= 1 && 1 < P.ph_hi) {
    if (PHON(1)) phase_ssm_mats(F);
    if (PHON(2)) { pg8::Gemm g{(const bf16_t*)(F.ws + WS_HN), F.wbf(W_IN), 1024, 1024, 1024, 0}; pg8::Order S; S.init(128, 13, G, bx);
      EpiProj E{PROJ, UA, SSQP, F.in[21]}; pg8::gemm_phase(F.lds, g, S, E); }
    }
    if (P.ph_lo <= 1 && 2 < P.ph_hi) { xcd_barrier(xbar); }
    if (P.ph_lo <= 2 && 2 < P.ph_hi) {
    if (PHON(3)) { phase_krope(F); phase_ssm_mats2(F); }
    if (PHON(4)) { pg8::Gemm g{PROJ + PC_CQ, F.wbf(W_UQ), NPROJ, 384, 384, 0}; pg8::Order S; S.init(128, 3, G, bx);
      EpiQ E{(bf16_t*)(F.ws + WS_Q), SSQP, (const float*)(F.ws + WS_COS), (const float*)(F.ws + WS_SIN), F.lds}; gemm_phase_drained(F.lds, g, S, E); }
    if (PHON(5)) { pg8::Gemm g{PROJ + PC_CKV, F.wbf(W_KV), NPROJ, 256, 256, 0}; pg8::Order S; S.init(128, 4, G, (bx + 128) % G);
      EpiKV E{(bf16_t*)(F.ws + WS_KV), SSQP}; pg8::gemm_phase(F.lds, g, S, E); }
    if (PHON(6) && bx >= G / 2) { pg8::Gemm g{UA, F.wbf(W_BT1), 384, 256, 256, 0}; pg8::Order S; S.init(256, 1, G - G / 2, bx - G / 2, 256, 0, 1);
      EpiS1 E{(float*)(F.ws + WS_HN)}; pg8::gemm_phase(F.lds, g, S, E); }
    }
    if (P.ph_lo <= 2 && 3 < P.ph_hi) { xcd_barrier(xbar); }
    if (P.ph_lo <= 3 && 3 < P.ph_hi) {
    if (PHON(7)) phase_scan(F);
    if (PHON(9)) { pg8::Gemm g{UA, F.wbf(W_BT3), 384, 384, 384, 0}; pg8::Order S; S.init(256, 1, G, bx, 256, 0, 1);
      EpiS3 E{(bf16_t*)(F.ws + WS_YG), UA, F.in[16], F.lds}; gemm_phase_drained(F.lds, g, S, E); }
    if (PHON(8)) phase_attn_mfma(F);
    }
    if (P.ph_lo <= 3 && 4 < P.ph_hi) { xcd_barrier(xbar); }
    if (P.ph_lo <= 4 && 4 < P.ph_hi) {
    if (PHON(11)) { pg8::Gemm g{(const bf16_t*)(F.ws + WS_YG), F.wbf(W_GLU), 16, 512, 512, (long)M_TOK * 16}; pg8::Order S; S.init(128, 2, G, bx);
      EpiGLU E{(const bf16_t*)(F.ws + WS_YG), (bf16_t*)(F.ws + WS_SSMO), F.in[18]}; pg8::gemm_phase(F.lds, g, S, E); }
    if (PHON(10)) { pg8::Gemm g{PROJ + PC_ATT, F.wbf(W_BA), NPROJ, 512, 512, 0}; pg8::Order S; S.init(128, 4, G, bx);
      EpiMerge<0> E{PROJ, (bf16_t*)(F.ws + WS_Q), (bf16_t*)(F.ws + WS_Q)}; pg8::gemm_phase(F.lds, g, S, E); }
    }
    if (P.ph_lo <= 4 && 5 < P.ph_hi) { xcd_barrier(xbar); }
    if (P.ph_lo <= 5 && 5 < P.ph_hi) {
    }
    if (P.ph_lo <= 6 && 6 < P.ph_hi) {
    if (PHON(12)) { pg8::Gemm g{(const bf16_t*)(F.ws + WS_SSMO), F.wbf(W_BS), 512, 512, 512, 0}; pg8::Order S; S.init(128, 4, G, bx);
      EpiMerge<1> E{PROJ, (bf16_t*)(F.ws + WS_Q), (bf16_t*)(F.ws + WS_HN2)}; pg8::gemm_phase(F.lds, g, S, E); }
    }
    if (P.ph_lo <= 6 && 7 < P.ph_hi) { xcd_barrier(xbar); }
    if (P.ph_lo <= 7 && 7 < P.ph_hi) {
    if (PHON(13)) { pg8::Gemm g{(const bf16_t*)(F.ws + WS_HN2), F.wbf(W_OUT), 1024, 1024, 1024, 0}; pg8::Order S; S.init(128, 4, G, bx);
      EpiStore E{(bf16_t*)(F.ws + WS_HN), 1024}; pg8::gemm_phase(F.lds, g, S, E); }
    }
    if (P.ph_lo <= 7 && 8 < P.ph_hi) { xcd_barrier(xbar); }
    if (P.ph_lo <= 8 && 8 < P.ph_hi) {
    if (PHON(14)) phase_rows_mid(F);
    }
    if (P.ph_lo <= 8 && 9 < P.ph_hi) { xcd_barrier(xbar); }
    if (P.ph_lo <= 9 && 9 < P.ph_hi) {
    if (PHON(15)) { pg8::Gemm g{(const bf16_t*)(F.ws + WS_HN2), F.wbf(W_UP), 1024, 1024, 1024, 0}; pg8::Order S; S.init(130, 22, G, bx, 254, -2, 0);
      EpiConv E{F.in[26], F.in[27], PROJ, F.lds};
      gemm_phase_drained(F.lds, g, S, E); }
    }
    if (P.ph_lo <= 9 && 10 < P.ph_hi) { xcd_barrier(xbar); }
    if (P.ph_lo <= 10 && 10 < P.ph_hi) {
    if (PHON(16)) { pg8::Gemm g{PROJ, F.wbf(W_DN), DFF, DFF, DFF, 0}; pg8::Order S; S.init(128, 4, G, bx);
      EpiStore E{(bf16_t*)(F.ws + WS_Q), 1024}; pg8::gemm_phase(F.lds, g, S, E); }
    }
    if (P.ph_lo <= 10 && 11 < P.ph_hi) { xcd_barrier(xbar); }
    if (P.ph_lo <= 11 && 11 < P.ph_hi) {
    if (PHON(17)) phase_rows_out(F);
    }
    if (P.ph_lo == 12) diag_hash(F, barw);
    if (P.ph_lo == 13) diag_write(F, barw);
}

extern "C" void kernel_launch(void* const* d_in, const int* in_sizes, int n_in, void* d_out, int out_size, void* d_ws, size_t ws_size, hipStream_t stream) {
    static int grid = 0;
    if (grid == 0) {
        if (n_in != 30 || ws_size < WS_NEED) { fprintf(stderr, "kernel_launch: unexpected n_in %d / ws %zu\n", n_in, ws_size); grid = -1; return; }
        int dev = 0, cus = 0, per_cu = 0;
        hipGetDevice(&dev); hipDeviceGetAttribute(&cus, hipDeviceAttributeMultiprocessorCount, dev);
        hipFuncSetAttribute((const void*)mega_fwd, hipFuncAttributeMaxDynamicSharedMemorySize, LDS_BYTES);
        hipOccupancyMaxActiveBlocksPerMultiprocessor(&per_cu, (const void*)mega_fwd, 512, LDS_BYTES);
        if (per_cu < 1) { fprintf(stderr, "kernel_launch: occupancy query says %d blocks/CU\n", per_cu); per_cu = 1; }
        grid = cus;
    }
    if (grid < 0) return;
    hipMemsetAsync((char*)d_ws + WS_BAR, 0, 32768, stream);
    Params p{};
    for (int i = 0; i < 30; ++i) p.in[i] = (const float*)d_in[i];
    p.out = (float*)d_out; p.ws = (unsigned char*)d_ws;
#if SINGLE_LAUNCH
    p.ph_lo = 0; p.ph_hi = 12;
    void* args[] = {&p};
    hipError_t e = hipLaunchCooperativeKernel((const void*)mega_fwd, dim3(grid), dim3(512), args, LDS_BYTES, stream);
#else
    hipError_t e = hipSuccess;
    const int nph = DIAG_AFTER >= 0 ? DIAG_AFTER + 1 : 12;
    for (int ph = 0; ph < nph; ++ph) { p.ph_lo = ph; p.ph_hi = ph + 1; hipLaunchKernelGGL(mega_fwd, dim3(grid), dim3(512), LDS_BYTES, stream, p); }
    if (DIAG_AFTER >= 0) for (int ph = 12; ph < 14; ++ph) { p.ph_lo = ph; p.ph_hi = ph + 1; hipLaunchKernelGGL(mega_fwd, dim3(grid), dim3(512), LDS_BYTES, stream, p); }
    e = hipGetLastError();
#endif
    if (e != hipSuccess) fprintf(stderr, "cooperative launch failed: %s (grid %d)\n", hipGetErrorString(e), grid);
}
```
